# Optimizing an MI355X kernel written in HIP

```python
import math
import jax, jax.numpy as jnp
from jax import lax
import numpy as np

D_MODEL = 2048
BATCH = 2
SEQ = 4096
DEPTH = 1

CHUNK = 64
N_MEM = 256
EPS = 1e-6
A_HEADS = 16
A_KV_HEADS = 2
A_HEAD_DIM = 64
WINDOW = 128
WINDOW_CHUNKS = WINDOW // CHUNK
A_WIDTH = A_HEADS * A_HEAD_DIM
B_HEADS = 4
B_HEAD_DIM = 128
B_WIDTH = B_HEADS * B_HEAD_DIM
IDX_HEADS = 4
IDX_DIM = 64
TOPK_MAX = 256
Q_BLOCK = 128
C_HEADS = 4
C_HEAD_DIM = 128
C_WIDTH = C_HEADS * C_HEAD_DIM
MIX_WIDTH = A_WIDTH + B_WIDTH + C_WIDTH
N_BUCKETS = 32
MAX_DISTANCE = 1024
N_BIAS_HEADS = A_HEADS + B_HEADS
SPLIT_SIZES = (A_WIDTH, A_KV_HEADS * A_HEAD_DIM, A_KV_HEADS * A_HEAD_DIM,
               B_WIDTH, B_WIDTH, B_WIDTH,
               IDX_HEADS * IDX_DIM, IDX_DIM, IDX_HEADS,
               C_WIDTH, MIX_WIDTH)
IN_WIDTH = sum(SPLIT_SIZES)

kernel_name = "hybrid_chunk_causal_swa_dsa_memory_block"


def rms_norm(x, g):
    xf = x.astype(jnp.float32)
    y = xf * lax.rsqrt(jnp.mean(xf * xf, axis=-1, keepdims=True) + EPS)
    return (y * g.astype(jnp.float32)).astype(x.dtype)


def t5_bucket(rel):
    nb = N_BUCKETS // 2
    max_exact = nb // 2
    side = jnp.where(rel > 0, nb, 0)
    n = jnp.abs(rel)
    nf = jnp.maximum(n, max_exact).astype(jnp.float32)
    large = max_exact + (jnp.log(nf / max_exact) / math.log(MAX_DISTANCE / max_exact)
                         * (nb - max_exact)).astype(jnp.int32)
    large = jnp.minimum(large, nb - 1)
    return side + jnp.where(n < max_exact, n, large)


def sliding_window_sink_attention(q, k, v, sinks, rel_bias):
    b, s = q.shape[0], q.shape[1]
    nc = s // CHUNK
    grp = A_HEADS // A_KV_HEADS
    pad = WINDOW_CHUNKS * CHUNK
    nk = (WINDOW_CHUNKS + 1) * CHUNK
    qc = q.reshape(b, nc, CHUNK, A_KV_HEADS, grp, A_HEAD_DIM)

    def band(t):
        tp = jnp.pad(t, ((0, 0), (pad, 0), (0, 0), (0, 0)))
        tp = tp.reshape(b, nc + WINDOW_CHUNKS, CHUNK, A_KV_HEADS, A_HEAD_DIM)
        return jnp.concatenate([tp[:, j:j + nc] for j in range(WINDOW_CHUNKS + 1)], axis=2)

    kb, vb = band(k), band(v)
    logits = jnp.einsum('bcqgrd,bckgd->bcgrqk', qc, kb).astype(jnp.float32) * (A_HEAD_DIM ** -0.5)
    rel = jnp.arange(nk)[None, :] - pad - jnp.arange(CHUNK)[:, None]
    bias = rel_bias[t5_bucket(rel)][..., :A_HEADS].astype(jnp.float32)
    bias = jnp.transpose(bias, (2, 0, 1)).reshape(A_KV_HEADS, grp, CHUNK, nk)
    kpos = (jnp.arange(nc)[:, None] - WINDOW_CHUNKS) * CHUNK + jnp.arange(nk)[None, :]
    valid = (kpos >= 0)[:, None, None, None, :]
    logits = jnp.where(valid, logits + bias, -jnp.inf)
    sink = sinks.astype(jnp.float32).reshape(A_KV_HEADS, grp, 1, 1)
    m = jnp.maximum(jnp.max(logits, axis=-1, keepdims=True), sink)
    p = jnp.exp(logits - m)
    denom = jnp.sum(p, axis=-1, keepdims=True) + jnp.exp(sink - m)
    probs = (p / denom).astype(v.dtype)
    out = jnp.einsum('bcgrqk,bckgd->bcqgrd', probs, vb)
    return out.reshape(b, s, A_WIDTH)


def indexed_sparse_attention(q, k, v, iq, ik, iw, rel_bias):
    b, s = q.shape[0], q.shape[1]
    topk = min(TOPK_MAX, s // 4)
    nqb = s // Q_BLOCK
    kchunk = jnp.arange(s) // CHUNK
    gather = jax.vmap(lambda t, i: t[i])

    def to_blocks(t):
        return jnp.moveaxis(t.reshape((b, nqb, Q_BLOCK) + t.shape[2:]), 1, 0)

    qpos_blocks = jnp.arange(s, dtype=jnp.int32).reshape(nqb, Q_BLOCK)

    def block(args):
        qb, iqb, iwb, qpos = args
        qchunk = qpos // CHUNK
        sc = jax.nn.relu(jnp.einsum('bqhd,bsd->bqhs', iqb, ik).astype(jnp.float32) * (IDX_DIM ** -0.5))
        isc = jnp.einsum('bqh,bqhs->bqs', iwb.astype(jnp.float32) * (IDX_HEADS ** -0.5), sc)
        adm = kchunk[None, :] <= qchunk[:, None]
        isc = jnp.where(adm[None], isc, -jnp.inf)
        _, idx = lax.top_k(isc, topk)
        kg = gather(k, idx)
        vg = gather(v, idx)
        logits = jnp.einsum('bqhd,bqkhd->bqhk', qb, kg).astype(jnp.float32) * (B_HEAD_DIM ** -0.5)
        rel = idx - qpos[None, :, None]
        bias = rel_bias[t5_bucket(rel)][..., A_HEADS:A_HEADS + B_HEADS].astype(jnp.float32)
        logits = logits + jnp.moveaxis(bias, -1, 2)
        valid = (idx // CHUNK) <= qchunk[None, :, None]
        logits = jnp.where(valid[:, :, None, :], logits, -jnp.inf)
        probs = jax.nn.softmax(logits, axis=-1).astype(v.dtype)
        return jnp.einsum('bqhk,bqkhd->bqhd', probs, vg)

    out = lax.map(block, (to_blocks(q), to_blocks(iq), to_blocks(iw), qpos_blocks))
    return jnp.moveaxis(out, 0, 1).reshape(b, s, B_WIDTH)


def memory_cross_attention(q, mk, mv):
    b, s = q.shape[0], q.shape[1]
    logits = jnp.einsum('bshd,bmhd->bhsm', q, mk).astype(jnp.float32) * (C_HEAD_DIM ** -0.5)
    probs = jax.nn.softmax(logits, axis=-1).astype(mv.dtype)
    return jnp.einsum('bhsm,bmhd->bshd', probs, mv).reshape(b, s, C_WIDTH)


def setup_inputs(seed: int = 0) -> dict:
    key = jax.random.key(seed)
    ks = jax.random.split(key, 10)
    f32 = jnp.float32
    x = jax.random.normal(ks[0], (BATCH, SEQ, D_MODEL), f32)
    mem = jax.random.normal(ks[1], (BATCH, N_MEM, D_MODEL), f32)
    g_norm = 1.0 + 0.01 * jax.random.normal(ks[2], (DEPTH, D_MODEL), f32)
    w_in = jax.random.normal(ks[3], (DEPTH, D_MODEL, IN_WIDTH), f32) * D_MODEL ** -0.5
    sinks = jax.random.normal(ks[4], (DEPTH, A_HEADS), f32)
    rel_bias = 0.5 * jax.random.normal(ks[5], (N_BUCKETS, N_BIAS_HEADS), f32)
    g_mem = 1.0 + 0.01 * jax.random.normal(ks[6], (DEPTH, D_MODEL), f32)
    w_mem_kv = jax.random.normal(ks[7], (DEPTH, D_MODEL, 2 * C_WIDTH), f32) * D_MODEL ** -0.5
    w_out = jax.random.normal(ks[8], (DEPTH, MIX_WIDTH, D_MODEL), f32) * MIX_WIDTH ** -0.5
    g_final = 1.0 + 0.01 * jax.random.normal(ks[9], (D_MODEL,), f32)
    return {"x": x, "mem": mem, "g_norm": g_norm, "w_in": w_in, "sinks": sinks,
            "rel_bias": rel_bias, "g_mem": g_mem, "w_mem_kv": w_mem_kv,
            "w_out": w_out, "g_final": g_final}


def reference(x, mem, g_norm, w_in, sinks, rel_bias, g_mem, w_mem_kv, w_out, g_final):
    b, s, _ = x.shape
    split_points = [int(p) for p in np.cumsum(SPLIT_SIZES)[:-1]]
    h = x
    for layer in range(DEPTH):
        hn = rms_norm(h, g_norm[layer])
        proj = hn @ w_in[layer]
        (aq, ak, av, bq, bk, bv, iq, ik, iw, cq, gate) = jnp.split(proj, split_points, axis=-1)
        oa = sliding_window_sink_attention(
            aq.reshape(b, s, A_HEADS, A_HEAD_DIM),
            ak.reshape(b, s, A_KV_HEADS, A_HEAD_DIM),
            av.reshape(b, s, A_KV_HEADS, A_HEAD_DIM),
            sinks[layer], rel_bias)
        ob = indexed_sparse_attention(
            bq.reshape(b, s, B_HEADS, B_HEAD_DIM),
            bk.reshape(b, s, B_HEADS, B_HEAD_DIM),
            bv.reshape(b, s, B_HEADS, B_HEAD_DIM),
            iq.reshape(b, s, IDX_HEADS, IDX_DIM), ik, iw, rel_bias)
        mkv = rms_norm(mem, g_mem[layer]) @ w_mem_kv[layer]
        mk, mv = jnp.split(mkv, [C_WIDTH], axis=-1)
        n_mem = mem.shape[1]
        oc = memory_cross_attention(
            cq.reshape(b, s, C_HEADS, C_HEAD_DIM),
            mk.reshape(b, n_mem, C_HEADS, C_HEAD_DIM),
            mv.reshape(b, n_mem, C_HEADS, C_HEAD_DIM))
        y = jnp.concatenate([oa, ob, oc], axis=-1) * jax.nn.silu(gate)
        h = h + y @ w_out[layer]
    return rms_norm(h, g_final)
```

```cpp
#include <hip/hip_runtime.h>
#include <cstdio>
#include <cstdint>
#include <cmath>

namespace pg8 {
#define PG8_LAS __attribute__((address_space(3)))
typedef unsigned short bf16_t;
typedef short bf16x8 __attribute__((ext_vector_type(8)));
typedef float f32x4 __attribute__((ext_vector_type(4)));
typedef unsigned u32x4 __attribute__((ext_vector_type(4)));
constexpr int BM = 256, BK = 64, HALF = 128, HTB = HALF * BK * 2  , STAGE_BYTES = 8 * HTB, NXCD = 8, WGM = 8;

__host__ __device__ __forceinline__ int lds_byte(int r, int c) { const int st = (r >> 4) * 2 + (c >> 5), rr = r & 15, cc = c & 31, ob = rr * 64 + cc * 2; return st * 1024 + (ob ^ (((ob >> 9) & 1) << 5)); }
__host__ __device__ __forceinline__ void stage_rc(int b, int& R, int& C) { const int st = b / 1024, sb = b % 1024, swz = sb ^ (((sb >> 9) & 1) << 5); R = (st >> 1) * 16 + swz / 64; C = (st & 1) * 32 + (swz % 64) / 2; }
__host__ __device__ __forceinline__ int perm32(int rho) { const int n = rho >> 4, i = rho & 15; return 8 * (i >> 2) + 4 * n + (i & 3); }

struct Unit { int pm, pn; };
struct Gemm { const bf16_t* A; const bf16_t* Bt; int M, N, K; };

struct StaticOrder {
    int nM, nN, nwg, G, c;
    __host__ __device__ void init(int M, int N, int G_, int c_) { nM = M / BM; nN = N / BM; nwg = nM * nN; G = G_; c = c_; }
    __host__ __device__ bool next(int i, Unit& u) const {
        const long L = (long)i * G + c; if (L >= nwg) return false;
        int wgid = (int)L; { const int q = nwg / NXCD, r = nwg % NXCD, xcd = wgid % NXCD, off = wgid / NXCD; wgid = (xcd < r ? xcd * (q + 1) : r * (q + 1) + (xcd - r) * q) + off; }
        const int nig = WGM * nN, gid = wgid / nig, fm = gid * WGM, gsz = (nM - fm) < WGM ? (nM - fm) : WGM;
        u.pm = fm + ((wgid % nig) % gsz); u.pn = (wgid % nig) / gsz; return true;
    }
    __device__ __forceinline__ void a_ready(const Unit&) const {}
    __device__ __forceinline__ void done(const Unit&) const {}
};
__device__ __forceinline__ unsigned cvt_pk_bf16(float lo, float hi) { unsigned r; asm volatile("v_cvt_pk_bf16_f32 %0, %1, %2" : "=v"(r) : "v"(lo), "v"(hi)); return r; }
typedef unsigned u32x4_dummy_unused;

constexpr int LDP = 5888;
struct EpiProj {
    static constexpr bool PERM = true, AFTER_DRAIN = false;
    bf16_t* proj; bf16_t* avT; bf16_t* bvT; bf16_t* mk; bf16_t* mvT;
    __device__ __forceinline__ static void st_row(bf16_t* p, const f32x4 v0, const f32x4 v1) {
        u32x4 w; w.x = cvt_pk_bf16(v0[0], v0[1]); w.y = cvt_pk_bf16(v0[2], v0[3]); w.z = cvt_pk_bf16(v1[0], v1[1]); w.w = cvt_pk_bf16(v1[2], v1[3]);
        *(u32x4*)p = w;
    }
    __device__ __forceinline__ static void st_tr(bf16_t* p, const size_t pitch, const f32x4 v0, const f32x4 v1) {
        const unsigned a = cvt_pk_bf16(v0[0], v0[1]), b = cvt_pk_bf16(v0[2], v0[3]), c = cvt_pk_bf16(v1[0], v1[1]), d = cvt_pk_bf16(v1[2], v1[3]);
        p[0] = (bf16_t)(a & 0xffffu); p[pitch] = (bf16_t)(a >> 16); p[2 * pitch] = (bf16_t)(b & 0xffffu); p[3 * pitch] = (bf16_t)(b >> 16);
        p[4 * pitch] = (bf16_t)(c & 0xffffu); p[5 * pitch] = (bf16_t)(c >> 16); p[6 * pitch] = (bf16_t)(d & 0xffffu); p[7 * pitch] = (bf16_t)(d >> 16);
    }
    __device__ __forceinline__ void operator()(const f32x4 (&acc)[2][2][4][2], const Unit& u, int wr, int wc, int fr, int fq) const {
        const int rl0 = wr * 64 + fr, cl0 = wc * 32 + 8 * fq;
        if (u.pn < 23) {
            const int row0 = u.pm * BM + rl0, colt = u.pn * BM + cl0;
            if (u.pn == 9 || u.pn == 10) {
#pragma unroll
                for (int ai = 0; ai < 2; ++ai)
#pragma unroll
                    for (int m = 0; m < 4; ++m) { const int row = row0 + ai * HALF + m * 16, b = row >> 12, s = row & 4095;
#pragma unroll
                        for (int bj = 0; bj < 2; ++bj) { const int cl = colt + bj * HALF - 2304, hd = cl >> 7, d = cl & 127;
                            st_tr(bvT + ((size_t)((b * 4 + hd) * 128 + d)) * 4096 + s, 4096, acc[ai][bj][m][0], acc[ai][bj][m][1]); } }
            } else if (u.pn == 4) {
#pragma unroll
                for (int ai = 0; ai < 2; ++ai)
#pragma unroll
                    for (int m = 0; m < 4; ++m) { const int row = row0 + ai * HALF + m * 16, b = row >> 12, s = row & 4095;
                        st_row(proj + (size_t)row * LDP + colt, acc[ai][0][m][0], acc[ai][0][m][1]);
                        const int cl = colt + HALF - 1152, grp = cl >> 6, d = cl & 63;
                        st_tr(avT + ((size_t)((b * 2 + grp) * 64 + d)) * 4096 + s, 4096, acc[ai][1][m][0], acc[ai][1][m][1]); }
            } else {
#pragma unroll
                for (int ai = 0; ai < 2; ++ai)
#pragma unroll
                    for (int m = 0; m < 4; ++m) { bf16_t* rowp = proj + (size_t)(row0 + ai * HALF + m * 16) * LDP + colt;
#pragma unroll
                        for (int bj = 0; bj < 2; ++bj) st_row(rowp + bj * HALF, acc[ai][bj][m][0], acc[ai][bj][m][1]); }
            }
        } else {
            const int row0 = (u.pm - 32) * BM + rl0, colt = (u.pn - 23) * BM + cl0;
            if (colt < 512) {
#pragma unroll
                for (int ai = 0; ai < 2; ++ai)
#pragma unroll
                    for (int m = 0; m < 4; ++m) { bf16_t* rowp = mk + (size_t)(row0 + ai * HALF + m * 16) * 512 + colt;
#pragma unroll
                        for (int bj = 0; bj < 2; ++bj) st_row(rowp + bj * HALF, acc[ai][bj][m][0], acc[ai][bj][m][1]); }
            } else {
#pragma unroll
                for (int ai = 0; ai < 2; ++ai)
#pragma unroll
                    for (int m = 0; m < 4; ++m) { const int row = row0 + ai * HALF + m * 16, b = row >> 8, mi = row & 255;
#pragma unroll
                        for (int bj = 0; bj < 2; ++bj) { const int cl = colt + bj * HALF - 512, hd = cl >> 7, d = cl & 127;
                            st_tr(mvT + ((size_t)((b * 4 + hd) * 128 + d)) * 256 + mi, 256, acc[ai][bj][m][0], acc[ai][bj][m][1]); } }
            }
        }
    }
};
struct EpiOut {
    static constexpr bool PERM = false, AFTER_DRAIN = false;
    const float* x; float* out; float* ssq;
    __device__ __forceinline__ void operator()(const f32x4 (&acc)[2][2][4][2], const Unit& u, int wr, int wc, int fr, int fq) const {
        const int row0 = u.pm * BM + wr * 64 + fr, col0 = u.pn * BM + wc * 32 + 4 * fq;
#pragma unroll
        for (int ai = 0; ai < 2; ++ai)
#pragma unroll
            for (int m = 0; m < 4; ++m) { const int row = row0 + ai * HALF + m * 16; const size_t off = (size_t)row * 2048 + col0; float s = 0.f;
#pragma unroll
                for (int bj = 0; bj < 2; ++bj)
#pragma unroll
                    for (int n = 0; n < 2; ++n) { const f32x4 xv = *(const f32x4*)(x + off + bj * HALF + n * 16); const f32x4 hv = acc[ai][bj][m][n] + xv;
                        *(f32x4*)(out + off + bj * HALF + n * 16) = hv; s += (hv[0] * hv[0] + hv[1] * hv[1]) + (hv[2] * hv[2] + hv[3] * hv[3]); }
                s += __shfl_xor(s, 16); s += __shfl_xor(s, 32);
                if (fq == 0) ssq[(size_t)row * 32 + u.pn * 4 + wc] = s; }
    }
};
template <class Epi, class Sched, bool ALIGN_EPI = false, bool SP2 = false>
__device__ __forceinline__ void gemm_phase(PG8_LAS unsigned char* lds, const Gemm g, const Sched& S, const Epi& E) {
    const int tid = threadIdx.x, wid = __builtin_amdgcn_readfirstlane(tid >> 6), lane = tid & 63, wr = wid >> 2, wc = wid & 3, fr = lane & 15, fq = lane >> 4;
    const int K = g.K, nt = K / BK;
    unsigned voffA[2], voffB[2];
#pragma unroll
    for (int i = 0; i < 2; ++i) { int R, C; stage_rc(tid * 16 + i * 8192, R, C); const int Rb = Epi::PERM ? ((R & ~31) + perm32(R & 31)) : R;
        voffA[i] = (unsigned)(R * K + C) * 2u; voffB[i] = (unsigned)(Rb * K + C) * 2u; }
    const size_t kstep = (size_t)(BK * 2);
    const size_t hstep = (size_t)HALF * K * 2;
    const size_t tstep = 2 * hstep;
    const unsigned ldsw = (unsigned)wid * 1024u;
    const int aoff = lds_byte(wr * 64 + fr, fq * 8), boff = lds_byte(wc * 32 + fr, fq * 8);
#define PG8_SA(b, h) (((b) * 2 + (h)) * HTB)
#define PG8_SB(b, h) ((4 + (b) * 2 + (h)) * HTB)
#define PG8_STAGE(bufoff, gbase, voff) do { _Pragma("unroll") for (int _i = 0; _i < 2; ++_i) \
        __builtin_amdgcn_global_load_lds((const unsigned*)((const char*)(gbase) + (voff)[_i]), (PG8_LAS unsigned*)(lds + (bufoff) + ldsw + _i * 8192), 16, 0, 0); } while (0)
#define PG8_LDA(dst, b, h) do { _Pragma("unroll") for (int m = 0; m < 4; ++m) _Pragma("unroll") for (int k = 0; k < 2; ++k) dst[m][k] = *(const PG8_LAS bf16x8*)(lds + PG8_SA(b, h) + aoff + m * 2048 + k * 1024); } while (0)
#define PG8_LDB(dst, b, h) do { _Pragma("unroll") for (int n = 0; n < 2; ++n) _Pragma("unroll") for (int k = 0; k < 2; ++k) dst[n][k] = *(const PG8_LAS bf16x8*)(lds + PG8_SB(b, h) + boff + n * 2048 + k * 1024); } while (0)
#define PG8_MMA(ai, bj, At, Bt) do { __builtin_amdgcn_s_setprio(1); _Pragma("unroll") for (int m = 0; m < 4; ++m) _Pragma("unroll") for (int n = 0; n < 2; ++n) _Pragma("unroll") for (int k = 0; k < 2; ++k) \
        acc[ai][bj][m][n] = __builtin_amdgcn_mfma_f32_16x16x32_bf16(Bt[n][k], At[m][k], acc[ai][bj][m][n], 0, 0, 0); __builtin_amdgcn_s_setprio(0); } while (0)
#define PG8_WAIT_V(n) asm volatile("s_waitcnt vmcnt(" #n ")" ::: "memory")
#define PG8_WAIT_L(n) asm volatile("s_waitcnt lgkmcnt(" #n ")" ::: "memory")
#define PG8_BAR __builtin_amdgcn_s_barrier()
#define PG8_SCHED __builtin_amdgcn_sched_barrier(0)
    Unit cur, nxt; int ui = 0;
    if (!S.next(0, cur)) return;
    f32x4 acc[2][2][4][2];
#pragma unroll
    for (int a = 0; a < 2; ++a)
#pragma unroll
        for (int b = 0; b < 2; ++b)
#pragma unroll
            for (int m = 0; m < 4; ++m)
#pragma unroll
                for (int n = 0; n < 2; ++n) acc[a][b][m][n] = (f32x4){0.f, 0.f, 0.f, 0.f};
    bf16x8 At[4][2], B0[2][2], B1[2][2];
    const char* cA = (const char*)g.A + (size_t)cur.pm * tstep; const char* cB = (const char*)g.Bt + (size_t)cur.pn * tstep;
    S.a_ready(cur);
    if constexpr (SP2) {
        PG8_STAGE(PG8_SB(0, 0), cB, voffB); PG8_STAGE(PG8_SB(0, 1), cB + hstep, voffB); PG8_STAGE(PG8_SA(0, 0), cA, voffA); PG8_STAGE(PG8_SA(0, 1), cA + hstep, voffA);
        if (wr == 1) PG8_BAR;
        PG8_WAIT_V(2); PG8_BAR;
        PG8_STAGE(PG8_SB(1, 0), cB + kstep, voffB); PG8_STAGE(PG8_SA(1, 0), cA + kstep, voffA); PG8_STAGE(PG8_SB(1, 1), cB + hstep + kstep, voffB);
        PG8_WAIT_V(6); PG8_BAR;
    } else {
        PG8_STAGE(PG8_SB(0, 0), cB, voffB); PG8_STAGE(PG8_SA(0, 0), cA, voffA); PG8_STAGE(PG8_SB(0, 1), cB + hstep, voffB); PG8_STAGE(PG8_SA(0, 1), cA + hstep, voffA);
        if (wr == 1) PG8_BAR;
        PG8_WAIT_V(4); PG8_BAR;
        PG8_STAGE(PG8_SB(1, 0), cB + kstep, voffB); PG8_STAGE(PG8_SA(1, 0), cA + kstep, voffA); PG8_STAGE(PG8_SB(1, 1), cB + hstep + kstep, voffB);
        PG8_WAIT_V(6); PG8_BAR;
    }
    for (;;) {
        const bool has_next = S.next(ui + 1, nxt);
        const char* nA = has_next ? (const char*)g.A + (size_t)nxt.pm * tstep : cA; const char* nB = has_next ? (const char*)g.Bt + (size_t)nxt.pn * tstep : cB;
        for (int t = 0; t < nt; t += 2) {
            const bool last = (t == nt - 2);
            const char* a1 = cA + (size_t)(t + 1) * kstep;
            const char* a2 = last ? nA : cA + (size_t)(t + 2) * kstep; const char* b2 = last ? nB : cB + (size_t)(t + 2) * kstep;
            const char* a3 = a2 + kstep; const char* b3 = b2 + kstep;
            if (last && has_next) S.a_ready(nxt);
            if constexpr (SP2) {
            PG8_LDB(B0, 0, 0); PG8_LDB(B1, 0, 1); PG8_SCHED; PG8_LDA(At, 0, 0); PG8_STAGE(PG8_SA(1, 1), a1 + hstep, voffA);
            PG8_WAIT_V(8); PG8_WAIT_L(0); PG8_BAR; PG8_MMA(0, 0, At, B0); PG8_MMA(0, 1, At, B1); PG8_BAR; PG8_SCHED;
            PG8_LDA(At, 0, 1); PG8_STAGE(PG8_SB(0, 0), b2, voffB); PG8_STAGE(PG8_SB(0, 1), b2 + hstep, voffB); PG8_STAGE(PG8_SA(0, 0), a2, voffA);
            PG8_WAIT_V(8); PG8_WAIT_L(0); PG8_BAR; PG8_MMA(1, 0, At, B0); PG8_MMA(1, 1, At, B1); PG8_BAR; PG8_SCHED;
            PG8_LDB(B0, 1, 0); PG8_LDB(B1, 1, 1); PG8_SCHED; PG8_LDA(At, 1, 0); PG8_STAGE(PG8_SA(0, 1), a2 + hstep, voffA);
            PG8_WAIT_V(8); PG8_WAIT_L(0); PG8_BAR; PG8_MMA(0, 0, At, B0); PG8_MMA(0, 1, At, B1); PG8_BAR; PG8_SCHED;
            PG8_LDA(At, 1, 1); PG8_STAGE(PG8_SB(1, 0), b3, voffB); PG8_STAGE(PG8_SB(1, 1), b3 + hstep, voffB); PG8_STAGE(PG8_SA(1, 0), a3, voffA);
            PG8_WAIT_V(8); PG8_WAIT_L(0); PG8_BAR; PG8_MMA(1, 0, At, B0); PG8_MMA(1, 1, At, B1); PG8_BAR; PG8_SCHED;
            } else {
            PG8_LDB(B0, 0, 0); PG8_SCHED; PG8_LDA(At, 0, 0); PG8_STAGE(PG8_SA(1, 1), a1 + hstep, voffA);
            PG8_WAIT_L(8); PG8_BAR; PG8_WAIT_L(0); PG8_MMA(0, 0, At, B0); PG8_BAR; PG8_SCHED;
            PG8_LDB(B1, 0, 1); PG8_STAGE(PG8_SB(0, 0), b2, voffB);
            PG8_BAR; PG8_WAIT_L(0); PG8_MMA(0, 1, At, B1); PG8_BAR;
            PG8_LDA(At, 0, 1); PG8_STAGE(PG8_SA(0, 0), a2, voffA);
            PG8_BAR; PG8_WAIT_L(0); PG8_MMA(1, 0, At, B0); PG8_BAR; PG8_SCHED;
            PG8_STAGE(PG8_SB(0, 1), b2 + hstep, voffB);
            PG8_WAIT_V(6); PG8_BAR; PG8_MMA(1, 1, At, B1); PG8_BAR;
            PG8_LDB(B0, 1, 0); PG8_SCHED; PG8_LDA(At, 1, 0); PG8_STAGE(PG8_SA(0, 1), a2 + hstep, voffA);
            PG8_WAIT_L(8); PG8_BAR; PG8_WAIT_L(0); PG8_MMA(0, 0, At, B0); PG8_BAR; PG8_SCHED;
            PG8_LDB(B1, 1, 1); PG8_STAGE(PG8_SB(1, 0), b3, voffB);
            PG8_BAR; PG8_WAIT_L(0); PG8_MMA(0, 1, At, B1); PG8_BAR;
            PG8_LDA(At, 1, 1); PG8_STAGE(PG8_SA(1, 0), a3, voffA);
            PG8_BAR; PG8_WAIT_L(0); PG8_MMA(1, 0, At, B0); PG8_BAR; PG8_SCHED;
            PG8_STAGE(PG8_SB(1, 1), b3 + hstep, voffB);
            PG8_WAIT_V(6); PG8_BAR; PG8_MMA(1, 1, At, B1); PG8_BAR;
            }
        }
        if constexpr (ALIGN_EPI) { if (wr == 0) PG8_BAR; }
        if constexpr (!Epi::AFTER_DRAIN) { E(acc, cur, wr, wc, fr, fq); S.done(cur); }
        if (!has_next) break;
#pragma unroll
        for (int a = 0; a < 2; ++a)
#pragma unroll
            for (int b = 0; b < 2; ++b)
#pragma unroll
                for (int m = 0; m < 4; ++m)
#pragma unroll
                    for (int n = 0; n < 2; ++n) acc[a][b][m][n] = (f32x4){0.f, 0.f, 0.f, 0.f};
        cur = nxt; cA = nA; cB = nB; ++ui;
        if constexpr (ALIGN_EPI) { if (wr == 1) PG8_BAR; }
    }
    PG8_WAIT_V(0);
    if constexpr (!ALIGN_EPI) { if (wr == 0) PG8_BAR; }
    PG8_BAR;
    if constexpr (Epi::AFTER_DRAIN) { E.fused(acc, cur, wr, wc, fr, fq, lds, wid, lane); S.done(cur); }
#undef PG8_SA
#undef PG8_SB
#undef PG8_STAGE
#undef PG8_LDA
#undef PG8_LDB
#undef PG8_MMA
#undef PG8_WAIT_V
#undef PG8_WAIT_L
#undef PG8_BAR
#undef PG8_SCHED
}
}
#define GAS __attribute__((address_space(1)))
#define LAS __attribute__((address_space(3)))
typedef unsigned short bf16;
typedef unsigned v4u __attribute__((ext_vector_type(4)));
typedef float f32x4 __attribute__((ext_vector_type(4)));
typedef short bf16x8 __attribute__((ext_vector_type(8)));
typedef GAS unsigned gu32;
typedef GAS unsigned long long gu64;
#define RLX_AGENT __ATOMIC_RELAXED, __HIP_MEMORY_SCOPE_AGENT
#define LDS_WAIT() asm volatile("s_waitcnt lgkmcnt(0)" ::: "memory")
#define VM_WAIT() asm volatile("s_waitcnt vmcnt(0)" ::: "memory")
__device__ __forceinline__ unsigned long long rt() { return __builtin_amdgcn_s_memrealtime(); }
__device__ __forceinline__ unsigned f2bf(float f) { unsigned u = __builtin_bit_cast(unsigned, f); return (u + 0x7fffu + ((u >> 16) & 1u)) >> 16; }
__device__ __forceinline__ unsigned pk2(float lo, float hi) { return f2bf(lo) | (f2bf(hi) << 16); }
#define XB_TMO      128
#define XB_XCNT(j)  (256  + 64 * (j))
#define XB_XSUB(j)  (1280 + 64 * (j))
#define XB_XGEN(j)  (2304 + 64 * (j))
#define XB_TOP      3328
#define XB_TOPGEN   3392
#define XCD_BAR_WORDS 3456
#define XB_SPIN_CAP (1u << 18)

__device__ __forceinline__ unsigned xb_ld(unsigned* p)              { return __hip_atomic_load(p, __ATOMIC_RELAXED, __HIP_MEMORY_SCOPE_AGENT); }
__device__ __forceinline__ unsigned xb_add(unsigned* p, unsigned v) { return __hip_atomic_fetch_add(p, v, __ATOMIC_RELAXED, __HIP_MEMORY_SCOPE_AGENT); }
__device__ __forceinline__ unsigned xb_xcc_id() { return (unsigned)__builtin_amdgcn_s_getreg((3 << 11) | 20) & 0xFu; }
#define XB_SPIN(cond, bar) do { unsigned _sp = 0; while (cond) { __builtin_amdgcn_s_sleep(1); \
    if ((++_sp & 255u) == 0u) { if (xb_ld(&(bar)[XB_TMO])) break; if (_sp > XB_SPIN_CAP) { atomicAdd(&(bar)[XB_TMO], 1u); break; } } } } while (0)

struct XcdBarrier {
    unsigned* bar; unsigned x;
    volatile LAS unsigned* st;
};

__device__ __forceinline__ XcdBarrier xcd_barrier_post(unsigned* bar, volatile LAS unsigned* st) {
    XcdBarrier b; b.bar = bar; b.x = xb_xcc_id(); b.st = st;
    if (threadIdx.x == 0) (void)xb_add(&bar[XB_XCNT(b.x)], 1u);
    return b;
}
__device__ __forceinline__ void xcd_barrier_complete(unsigned* bar, unsigned x, unsigned& nloc, unsigned& nx) {
    const unsigned G = gridDim.x * gridDim.y * gridDim.z;
    unsigned sum, cnt, mine, sp = 0u;
    for (;;) {
        sum = 0u; cnt = 0u; mine = 0u;
#pragma unroll
        for (unsigned j = 0; j < 16; ++j) { const unsigned c = xb_ld(&bar[XB_XCNT(j)]); sum += c; cnt += (c > 0u) ? 1u : 0u; mine = (j == x) ? c : mine; }
        if (sum == G) break;
        __builtin_amdgcn_s_sleep(1);
        if ((++sp & 255u) == 0u) { if (xb_ld(&bar[XB_TMO])) break; if (sp > XB_SPIN_CAP) { atomicAdd(&bar[XB_TMO], 1u); break; } }
    }
    nloc = mine > 0u ? mine : 1u; nx = cnt > 0u ? cnt : 1u;
}

__device__ __forceinline__ void xcd_barrier(const XcdBarrier& b) {
    asm volatile("s_waitcnt vmcnt(0)" ::: "memory");
    __syncthreads();
    if (threadIdx.x == 0) {
        unsigned* bar = b.bar;
        __builtin_amdgcn_s_waitcnt(0);
        unsigned nloc = b.st[0], nx = b.st[1];
        if (nloc == 0u) { xcd_barrier_complete(bar, b.x, nloc, nx); b.st[0] = nloc; b.st[1] = nx; }
        const unsigned old = xb_add(&bar[XB_XSUB(b.x)], 1u);
        const unsigned gen = old / nloc;
        if (old + 1u == (gen + 1u) * nloc) {
            __builtin_amdgcn_fence(__ATOMIC_RELEASE, "agent");
            asm volatile("s_waitcnt vmcnt(0)" ::: "memory");
            const unsigned og = xb_add(&bar[XB_TOP], 1u);
            const unsigned tg = og / nx;
            if (og + 1u == (tg + 1u) * nx) xb_add(&bar[XB_TOPGEN], 1u);
            else XB_SPIN(xb_ld(&bar[XB_TOPGEN]) == tg, bar);
            __builtin_amdgcn_fence(__ATOMIC_ACQUIRE, "agent");
            xb_add(&bar[XB_XGEN(b.x)], 1u);
            asm volatile("s_waitcnt vmcnt(0)" ::: "memory");
        } else {
            XB_SPIN(xb_ld(&bar[XB_XGEN(b.x)]) == gen, bar);
            __builtin_amdgcn_fence(__ATOMIC_ACQUIRE, "agent");
            asm volatile("s_waitcnt vmcnt(0)" ::: "memory");
        }
    }
    __syncthreads();
}

constexpr int NWAVES = 8;
constexpr int NB = 2, SEQ = 4096, DM = 2048, MTOK = NB * SEQ, NMEM = 256, MMEM = NB * NMEM;
constexpr int LDP = pg8::LDP, NSRC = 5700;
constexpr int C_AQ = 0, C_AK = 1024, C_AV = 1152, C_BQ = 1280, C_BK = 1792, C_BV = 2304, C_IQ = 2816, C_IK = 3072, C_IW = 3136, C_CQ = 3328, C_GATE = 3840;
constexpr float EPS = 1e-6f, LOG2E = 1.4426950408889634f;
constexpr int NBH = 20;
constexpr int BIASB_N = 4160;
#ifndef MK_N_LAUNCHES
#define MK_N_LAUNCHES 1
#endif
constexpr int N_LAUNCHES = MK_N_LAUNCHES;
constexpr int N_PHASES = 6;

constexpr size_t MiB = 1u << 20;
constexpr size_t WS_CTL = 0, CTL_ZERO_BYTES = 1 * MiB;
constexpr size_t WS_WINT = 2 * MiB;
constexpr size_t WS_WMEMT = 25 * MiB;
constexpr size_t WS_WOUTT = 29 * MiB;
constexpr size_t WS_XN = 38 * MiB;
constexpr size_t WS_MEMN = 70 * MiB;
constexpr size_t WS_PROJ = 72 * MiB;
constexpr size_t WS_MK = 164 * MiB;
constexpr size_t WS_MVT = WS_MK + MiB / 2;
constexpr size_t WS_AVT = 165 * MiB;
constexpr size_t WS_BVT = 167 * MiB;
constexpr size_t WS_MASK = 175 * MiB;
constexpr size_t WS_BIASA = 179 * MiB;
constexpr size_t WS_BIASB = 180 * MiB;
constexpr size_t WS_Y = 181 * MiB;
constexpr size_t WS_SSQ = 213 * MiB;
constexpr size_t WS_END = 214 * MiB;
static_assert(WS_WINT + (size_t)5888 * 2048 * 2 == WS_WMEMT && WS_XN + (size_t)MTOK * DM * 2 == WS_MEMN && WS_PROJ + (size_t)MTOK * LDP * 2 <= WS_MK, "d_ws map");
constexpr int CW_TMO = 0, CW_CODE = 1, CW_BAR = 4096, CW_Q = 8192;

constexpr int RING_OFF = 0, RING_BYTES = 131072;
constexpr int LDSCTL_OFF = RING_BYTES, MISC_OFF = LDSCTL_OFF + 320;
constexpr int LDS_BYTES = 147456;

typedef float f32x16 __attribute__((ext_vector_type(16)));
typedef unsigned u32x2 __attribute__((ext_vector_type(2)));
typedef float f32x2_t __attribute__((ext_vector_type(2)));
typedef __bf16 bf16x2_t __attribute__((ext_vector_type(2)));
#define DI __device__ __forceinline__
#define MFMA32(a, b, c) __builtin_amdgcn_mfma_f32_32x32x16_bf16((a), (b), (c), 0, 0, 0)
DI int crow(int r, int hi) { return (r & 3) + 8 * (r >> 2) + 4 * hi; }
DI float bf2f(unsigned v) { return __uint_as_float(v << 16); }
DI unsigned cvtpk(float lo, float hi) { f32x2_t v = {lo, hi}; bf16x2_t b = __builtin_convertvector(v, bf16x2_t); return __builtin_bit_cast(unsigned, b); }
DI float ex2(float v) { return __builtin_amdgcn_exp2f(v); }
DI float wave_sum(float v) {
#pragma unroll
    for (int o = 1; o < 64; o <<= 1) v += __shfl_xor(v, o);
    return v;
}

struct Frame {
    LAS unsigned char* lds;
    volatile LAS unsigned* MISC;
    gu32* ctl;
    int tid, lane, wave, vcu, G;
    const float *x, *mem, *g_norm, *w_in, *sinks, *rel_bias, *g_mem, *w_mem_kv, *w_out, *g_final; float* out;
    bf16 *WinT, *WmemT, *WoutT, *XN, *MEMN, *PROJ, *MK, *MVT, *AVT, *BVT, *Y; unsigned* MASK; float *BIASA, *BIASB, *SSQ;
};

DI void p0_transpose_item(const float* W, int Nsrc, int K, bf16* WT, int mode, LAS float* scr, int item, int nblk, int lane) {
    const int kb = item / nblk, nb = item % nblk, k0 = 64 * kb, n0 = 32 * nb;
    const int nn = n0 + (lane & 31);
    int sc = nn; if (mode == 1) sc = nn < 3140 ? nn : (nn < 3328 ? -1 : nn - 188);
#pragma unroll 8
    for (int i = 0; i < 32; ++i) { const int kk = 2 * i + (lane >> 5); scr[kk * 33 + (lane & 31)] = sc >= 0 ? W[(size_t)(k0 + kk) * Nsrc + sc] : 0.f; }
    LDS_WAIT(); asm volatile("" ::: "memory");
    const int c = lane & 7;
#pragma unroll
    for (int j = 0; j < 4; ++j) { const int n = (lane >> 3) + 8 * j; const LAS float* s = scr + (8 * c) * 33 + n;
        v4u o; o.x = pk2(s[0 * 33], s[1 * 33]); o.y = pk2(s[2 * 33], s[3 * 33]); o.z = pk2(s[4 * 33], s[5 * 33]); o.w = pk2(s[6 * 33], s[7 * 33]);
        *(GAS v4u*)(WT + (size_t)(n0 + n) * K + k0 + 8 * c) = o; }
    LDS_WAIT(); asm volatile("" ::: "memory");
}
DI void rms_row_to_bf16(const float* xrow, const float* g, bf16* orow, int lane) {
    const GAS f32x4* xr = (const GAS f32x4*)xrow + lane; const GAS f32x4* gr = (const GAS f32x4*)g + lane;
    f32x4 v[8]; float s = 0.f;
#pragma unroll
    for (int j = 0; j < 8; ++j) { v[j] = xr[64 * j]; s += (v[j].x * v[j].x + v[j].y * v[j].y) + (v[j].z * v[j].z + v[j].w * v[j].w); }
    const float rstd = 1.f / sqrtf(wave_sum(s) * (1.f / DM) + EPS);
    GAS unsigned long long* o8 = (GAS unsigned long long*)orow + lane;
#pragma unroll
    for (int j = 0; j < 8; ++j) { const f32x4 gv = gr[64 * j];
        o8[64 * j] = (unsigned long long)pk2(v[j].x * rstd * gv.x, v[j].y * rstd * gv.y) | ((unsigned long long)pk2(v[j].z * rstd * gv.z, v[j].w * rstd * gv.w) << 32); }
}
DI int t5_bucket(int rel) {
    const int n = rel < 0 ? -rel : rel; int b = n;
    if (n >= 8) b = 8 + (n >= 15) + (n >= 27) + (n >= 50) + (n >= 91) + (n >= 166) + (n >= 305) + (n >= 559);
    return b + (rel > 0 ? 16 : 0);
}
DI void p0_prologue(Frame& F) {
    LAS float* scr = (LAS float*)(F.lds + RING_OFF + F.wave * 16384);
    const int gw = F.vcu * NWAVES + F.wave, NGW = F.G * NWAVES;
    constexpr int I_IN = 32 * 184, I_OUT = 32 * 64, I_MEM = 32 * 32, NITEMS = I_IN + I_OUT + I_MEM;
    for (int it = gw; it < NITEMS; it += NGW) {
        int r = it;
        if (r < I_IN) { p0_transpose_item(F.w_in, NSRC, DM, F.WinT, 1, scr, r, 184, F.lane); continue; } r -= I_IN;
        if (r < I_OUT) { p0_transpose_item(F.w_out, DM, DM, F.WoutT, 0, scr, r, 64, F.lane); continue; } r -= I_OUT;
        p0_transpose_item(F.w_mem_kv, 1024, DM, F.WmemT, 0, scr, r, 32, F.lane);
    }
    for (int m = gw; m < MTOK + MMEM; m += NGW) {
        if (m < MTOK) rms_row_to_bf16(F.x + (size_t)m * DM, F.g_norm, F.XN + (size_t)m * DM, F.lane);
        else rms_row_to_bf16(F.mem + (size_t)(m - MTOK) * DM, F.g_mem, F.MEMN + (size_t)(m - MTOK) * DM, F.lane);
    }
    const int gt = (int)blockIdx.x * (NWAVES * 64) + F.tid, NGT = F.G * NWAVES * 64;
    for (int i = gt; i < 16 * 64 * 192 + 4 * BIASB_N; i += NGT) {
        if (i < 16 * 64 * 192) { const int a = i / (64 * 192), r2 = i % (64 * 192), qi = r2 / 192, kj = r2 % 192;
            F.BIASA[i] = F.rel_bias[t5_bucket(kj - 128 - qi) * NBH + a] * LOG2E; }
        else { const int j = i - 16 * 64 * 192, hd = j / BIASB_N, e = j % BIASB_N;
            F.BIASB[j] = F.rel_bias[t5_bucket(e - 4095) * NBH + 16 + hd] * LOG2E; }
    }
}

template <int HD> struct ASt { f32x16 o[HD / 32]; float m, l; };
template <int HD> DI void ast_init(ASt<HD>& st) {
#pragma unroll
    for (int dt = 0; dt < HD / 32; ++dt)
#pragma unroll
        for (int i = 0; i < 16; ++i) st.o[dt][i] = 0.f;
    st.m = -INFINITY; st.l = 0.f;
}
template <int HD> DI f32x16 qk_tile(const bf16* krow, const bf16x8 (&qf)[HD / 16]) {
    f32x16 s;
#pragma unroll
    for (int i = 0; i < 16; ++i) s[i] = 0.f;
#pragma unroll
    for (int ks = 0; ks < HD / 16; ++ks) { const bf16x8 a = *(const GAS bf16x8*)(krow + 16 * ks); s = MFMA32(a, qf[ks], s); }
    return s;
}
template <int HD> DI void softmax_pv(ASt<HD>& st, f32x16& x, const bf16* vt, const size_t dtstride) {
    float m0 = fmaxf(fmaxf(x[0], x[1]), fmaxf(x[2], x[3])), m1 = fmaxf(fmaxf(x[4], x[5]), fmaxf(x[6], x[7]));
    float m2 = fmaxf(fmaxf(x[8], x[9]), fmaxf(x[10], x[11])), m3 = fmaxf(fmaxf(x[12], x[13]), fmaxf(x[14], x[15]));
    float mx = fmaxf(fmaxf(m0, m1), fmaxf(m2, m3));
    mx = fmaxf(mx, __shfl_xor(mx, 32));
    const float mnew = fmaxf(st.m, mx);
    const float muse = (mnew == -INFINITY) ? 0.f : mnew;
    if (__any(mnew != st.m)) {
        const float alpha = ex2(st.m - muse);
        st.l *= alpha;
#pragma unroll
        for (int dt = 0; dt < HD / 32; ++dt)
#pragma unroll
            for (int i = 0; i < 16; ++i) st.o[dt][i] *= alpha;
        st.m = mnew;
    }
    float ps = 0.f;
#pragma unroll
    for (int i = 0; i < 16; ++i) { x[i] = ex2(x[i] - muse); ps += x[i]; }
    st.l += ps;
#pragma unroll
    for (int kk = 0; kk < 2; ++kk) {
        v4u pw; pw.x = cvtpk(x[8 * kk], x[8 * kk + 1]); pw.y = cvtpk(x[8 * kk + 2], x[8 * kk + 3]); pw.z = cvtpk(x[8 * kk + 4], x[8 * kk + 5]); pw.w = cvtpk(x[8 * kk + 6], x[8 * kk + 7]);
        const bf16x8 pf = __builtin_bit_cast(bf16x8, pw);
#pragma unroll
        for (int dt = 0; dt < HD / 32; ++dt) {
            const u32x2 v0 = *(const GAS u32x2*)(vt + dt * dtstride + 16 * kk), v1 = *(const GAS u32x2*)(vt + dt * dtstride + 16 * kk + 8);
            v4u vw; vw.x = v0.x; vw.y = v0.y; vw.z = v1.x; vw.w = v1.y;
            st.o[dt] = MFMA32(__builtin_bit_cast(bf16x8, vw), pf, st.o[dt]);
        }
    }
}
template <int HD> DI void attn_store(const ASt<HD>& st, const float inv, const bf16* gate_row, bf16* yrow, const int hi) {
#pragma unroll
    for (int dt = 0; dt < HD / 32; ++dt)
#pragma unroll
        for (int g4 = 0; g4 < 4; ++g4) {
            const int d = 32 * dt + 8 * g4 + 4 * hi;
            const u32x2 gv = *(const GAS u32x2*)(gate_row + d);
            float gg[4] = {bf2f(gv.x & 0xffffu), bf2f(gv.x >> 16), bf2f(gv.y & 0xffffu), bf2f(gv.y >> 16)}, yv[4];
#pragma unroll
            for (int j = 0; j < 4; ++j) { const float sg = gg[j] / (1.f + ex2(-gg[j] * LOG2E)); yv[j] = st.o[dt][4 * g4 + j] * inv * sg; }
            u32x2 w; w.x = cvtpk(yv[0], yv[1]); w.y = cvtpk(yv[2], yv[3]);
            *(GAS u32x2*)(yrow + d) = w;
        }
}

DI void aattn_item(Frame& F, const int b, const int c, const int grp) {
    const int lane = F.lane, q = lane & 31, hi = lane >> 5, a = grp * 8 + F.wave;
    const float sink2 = F.sinks[a] * LOG2E, c1 = 0.125f * LOG2E;
    const int smin = c >= 2 ? 0 : (2 - c) * 2;
#pragma unroll 1
    for (int g = 0; g < 2; ++g) {
        const int qin = c * 64 + g * 32 + q; const size_t row = (size_t)b * SEQ + qin;
        bf16x8 qf[4];
#pragma unroll
        for (int ks = 0; ks < 4; ++ks) qf[ks] = *(const GAS bf16x8*)(F.PROJ + row * LDP + C_AQ + a * 64 + 16 * ks + 8 * hi);
        ASt<64> st; ast_init(st);
        const long kp0 = (long)b * SEQ + (long)(c - 2) * 64;
        const bf16* kbase = F.PROJ + (kp0 + q) * LDP + C_AK + grp * 64 + 8 * hi;
        const bf16* vbase = F.AVT + ((long)((b * 2 + grp) * 64 + q)) * SEQ + (long)(c - 2) * 64 + 4 * hi;
        const float* btab = F.BIASA + ((size_t)(a * 64 + g * 32 + q)) * 192 + 4 * hi;
#pragma unroll 1
        for (int s = smin; s < 6; ++s) {
            f32x16 x = qk_tile<64>(kbase + (long)(32 * s) * LDP, qf);
#pragma unroll
            for (int g4 = 0; g4 < 4; ++g4) { const f32x4 bv = *(const GAS f32x4*)(btab + 32 * s + 8 * g4);
#pragma unroll
                for (int j = 0; j < 4; ++j) x[4 * g4 + j] = fmaf(x[4 * g4 + j], c1, bv[j]); }
            softmax_pv<64>(st, x, vbase + 32 * s, (size_t)32 * SEQ);
        }
        const float mf = fmaxf(st.m, sink2), a0 = ex2(st.m - mf);
        const float ltot = (st.l + __shfl_xor(st.l, 32)) * a0 + ex2(sink2 - mf);
        attn_store<64>(st, a0 / ltot, F.PROJ + row * LDP + C_GATE + a * 64, F.Y + row * DM + a * 64, hi);
    }
}
DI void cattn_item(Frame& F, const int b, const int qb) {
    const int lane = F.lane, q = lane & 31, hi = lane >> 5, hd = F.wave & 3, g = F.wave >> 2;
    const float c1 = 0.08838834764831845f * LOG2E;
    const size_t row = (size_t)b * SEQ + qb * 64 + g * 32 + q;
    bf16x8 qf[8];
#pragma unroll
    for (int ks = 0; ks < 8; ++ks) qf[ks] = *(const GAS bf16x8*)(F.PROJ + row * LDP + C_CQ + hd * 128 + 16 * ks + 8 * hi);
    ASt<128> st; ast_init(st);
    const bf16* kbase = F.MK + ((size_t)(b * NMEM + q)) * 512 + hd * 128 + 8 * hi;
    const bf16* vbase = F.MVT + ((size_t)((b * 4 + hd) * 128 + q)) * NMEM + 4 * hi;
#pragma unroll 1
    for (int s = 0; s < 8; ++s) {
        f32x16 x = qk_tile<128>(kbase + (size_t)(32 * s) * 512, qf);
#pragma unroll
        for (int i = 0; i < 16; ++i) x[i] *= c1;
        softmax_pv<128>(st, x, vbase + 32 * s, (size_t)32 * NMEM);
    }
    const float ltot = st.l + __shfl_xor(st.l, 32);
    attn_store<128>(st, 1.f / ltot, F.PROJ + row * LDP + C_GATE + 1536 + hd * 128, F.Y + row * DM + 1536 + hd * 128, hi);
}
DI void battn_chunk(Frame& F, const int b, const int c, const int hd) {
    const int lane = F.lane, q = lane & 31, hi = lane >> 5, g = F.wave & 1, kq = F.wave >> 1;
    const int qin = c * 64 + g * 32 + q; const size_t row = (size_t)b * SEQ + qin;
    const float c1 = 0.08838834764831845f * LOG2E;
    bf16x8 qf[8];
#pragma unroll
    for (int ks = 0; ks < 8; ++ks) qf[ks] = *(const GAS bf16x8*)(F.PROJ + row * LDP + C_BQ + hd * 128 + 16 * ks + 8 * hi);
    ASt<128> st; ast_init(st);
    const bf16* kbase = F.PROJ + ((size_t)b * SEQ + q) * LDP + C_BK + hd * 128 + 8 * hi;
    const bf16* vbase = F.BVT + ((size_t)((b * 4 + hd) * 128 + q)) * SEQ + 4 * hi;
    const unsigned* mrow = F.MASK + row * 128;
    const float* btab = F.BIASB + hd * BIASB_N + 4095 - qin;
    const float bfar = F.rel_bias[15 * NBH + 16 + hd] * LOG2E;
#pragma unroll 1
    for (int t = kq; t <= c; t += 4) {
#pragma unroll 1
        for (int sub = 0; sub < 2; ++sub) {
            const int key0 = 64 * t + 32 * sub;
            const unsigned mb = *(const GAS unsigned*)(mrow + 2 * t + sub);
            f32x16 x = qk_tile<128>(kbase + (size_t)key0 * LDP, qf);
            if ((c * 64 + g * 32) - (key0 + 31) >= 559) {
#pragma unroll
                for (int i = 0; i < 16; ++i) x[i] = ((mb >> crow(i, hi)) & 1u) ? fmaf(x[i], c1, bfar) : -INFINITY;
            } else {
#pragma unroll
                for (int i = 0; i < 16; ++i) { const float bias = *(const GAS float*)(btab + key0 + crow(i, hi)); x[i] = ((mb >> crow(i, hi)) & 1u) ? fmaf(x[i], c1, bias) : -INFINITY; }
            }
            softmax_pv<128>(st, x, vbase + key0, (size_t)32 * SEQ);
        }
    }
    LAS float* part = (LAS float*)(F.lds + RING_OFF);
    if (kq != 0) { LAS float* p = part + ((g * 3 + kq - 1) * 66) * 64 + lane; p[0] = st.m; p[64] = st.l;
#pragma unroll
        for (int dt = 0; dt < 4; ++dt)
#pragma unroll
            for (int i = 0; i < 16; ++i) p[(2 + dt * 16 + i) * 64] = st.o[dt][i]; }
    __syncthreads();
    if (kq == 0) {
#pragma unroll 1
        for (int k = 0; k < 3; ++k) { const LAS float* p = part + ((g * 3 + k) * 66) * 64 + lane;
            const float mi = p[0], li = p[64], mnew = fmaxf(st.m, mi), muse = (mnew == -INFINITY) ? 0.f : mnew, a0 = ex2(st.m - muse), a1 = ex2(mi - muse);
            st.l = st.l * a0 + li * a1; st.m = mnew;
#pragma unroll
            for (int dt = 0; dt < 4; ++dt)
#pragma unroll
                for (int i = 0; i < 16; ++i) st.o[dt][i] = st.o[dt][i] * a0 + p[(2 + dt * 16 + i) * 64] * a1; }
        const float ltot = st.l + __shfl_xor(st.l, 32);
        attn_store<128>(st, 1.f / ltot, F.PROJ + row * LDP + C_GATE + 1024 + hd * 128, F.Y + row * DM + 1024 + hd * 128, hi);
    }
    __syncthreads();
}

DI f32x16 idx_tile(const bf16* ikrow, const bf16x8 (&qf)[4][4], const float (&w)[4]) {
    bf16x8 kf[4];
#pragma unroll
    for (int ks = 0; ks < 4; ++ks) kf[ks] = *(const GAS bf16x8*)(ikrow + 16 * ks);
    f32x16 isc;
#pragma unroll
    for (int h4 = 0; h4 < 4; ++h4) {
        f32x16 s;
#pragma unroll
        for (int i = 0; i < 16; ++i) s[i] = 0.f;
#pragma unroll
        for (int ks = 0; ks < 4; ++ks) s = MFMA32(kf[ks], qf[h4][ks], s);
#pragma unroll
        for (int i = 0; i < 16; ++i) { const float v = fmaxf(s[i], 0.f); isc[i] = (h4 == 0) ? v * w[0] : __builtin_fmaf(v, w[h4], isc[i]); }
    }
#pragma unroll
    for (int i = 0; i < 16; ++i) isc[i] += 0.f;
    return isc;
}
DI unsigned sortable(float v) { const unsigned u = __float_as_uint(v); return u ^ ((unsigned)((int)u >> 31) | 0x80000000u); }
DI unsigned long long comp_key(float v, int key) { return ((unsigned long long)sortable(v) << 16) | (unsigned long long)(0xFFFFu - (unsigned)key); }

DI void sel_item(Frame& F, const int b, const int c, const int g) {
    const int lane = F.lane, q = lane & 31, hi = lane >> 5, wave = F.wave;
    const int t0 = c * 64 + g * 32, nsub = 2 * (c + 1);
    const size_t row = (size_t)b * SEQ + t0 + q;
    unsigned* mrow = F.MASK + row * 128;
    if (c <= 3) {
        for (int s = wave; s < nsub; s += NWAVES) if (hi == 0) mrow[s] = 0xFFFFFFFFu;
        return;
    }
    bf16x8 qf[4][4];
#pragma unroll
    for (int h4 = 0; h4 < 4; ++h4)
#pragma unroll
        for (int ks = 0; ks < 4; ++ks) qf[h4][ks] = *(const GAS bf16x8*)(F.PROJ + row * LDP + C_IQ + h4 * 64 + 16 * ks + 8 * hi);
    float w[4];
    { const u32x2 wv = *(const GAS u32x2*)(F.PROJ + row * LDP + C_IW);
      w[0] = bf2f(wv.x & 0xffffu) * 0.0625f; w[1] = bf2f(wv.x >> 16) * 0.0625f; w[2] = bf2f(wv.y & 0xffffu) * 0.0625f; w[3] = bf2f(wv.y >> 16) * 0.0625f; }
    const bf16* ikbase = F.PROJ + ((size_t)b * SEQ + q) * LDP + C_IK + 8 * hi;
    LAS unsigned* hist = (LAS unsigned*)(F.lds + RING_OFF);
    volatile LAS unsigned* stt = (volatile LAS unsigned*)(F.lds + RING_OFF + 32768);
    if (F.tid < 32) { stt[F.tid] = 0u; stt[32 + F.tid] = 0u; stt[64 + F.tid] = 256u; stt[96 + F.tid] = 0u; stt[128 + F.tid] = 0u; stt[160 + F.tid] = 0u; }
#pragma unroll 1
    for (int pass = 0; pass < 6; ++pass) {
        const int sh = 40 - 8 * pass;
        for (int i = F.tid; i < 256 * 32; i += NWAVES * 64) hist[i] = 0u;
        __syncthreads();
        const unsigned long long prefix = ((unsigned long long)stt[32 + q] << 32) | stt[q];
        const bool active = stt[96 + q] == 0u;
#pragma unroll 1
        for (int s = wave; s < nsub; s += NWAVES) {
            const f32x16 isc = idx_tile(ikbase + (size_t)(32 * s) * LDP, qf, w);
#pragma unroll
            for (int i = 0; i < 16; ++i) {
                const unsigned long long ck = comp_key(isc[i], 32 * s + crow(i, hi));
                if (active && ((ck >> (sh + 8)) == prefix)) __hip_atomic_fetch_add(hist + ((unsigned)(ck >> sh) & 255u) * 32 + q, 1u, __ATOMIC_RELAXED, __HIP_MEMORY_SCOPE_WORKGROUP);
            }
        }
        __syncthreads();
#pragma unroll 1
        for (int qq = 0; qq < 4; ++qq) {
            const int qi = wave * 4 + qq;
            if (stt[96 + qi] != 0u) continue;
            const unsigned r = stt[64 + qi];
            const int b0 = 255 - 4 * lane;
            const unsigned c0 = hist[(b0) * 32 + qi], c1 = hist[(b0 - 1) * 32 + qi], c2 = hist[(b0 - 2) * 32 + qi], c3 = hist[(b0 - 3) * 32 + qi];
            const unsigned sum = c0 + c1 + c2 + c3; unsigned incl = sum;
#pragma unroll
            for (int o = 1; o < 64; o <<= 1) { const unsigned t = __shfl_up(incl, o); if (lane >= o) incl += t; }
            const unsigned ex = incl - sum;
            if (ex < r && r <= incl) {
                unsigned run = ex, cnt = c0; int d = 0;
                if (run + c0 < r) { run += c0; d = 1; cnt = c1; if (run + c1 < r) { run += c1; d = 2; cnt = c2; if (run + c2 < r) { run += c2; d = 3; cnt = c3; } } }
                const unsigned rnew = r - run;
                const unsigned long long pref = ((((unsigned long long)stt[32 + qi] << 32) | stt[qi]) << 8) | (unsigned long long)(b0 - d);
                stt[qi] = (unsigned)pref; stt[32 + qi] = (unsigned)(pref >> 32); stt[64 + qi] = rnew;
                if (cnt == rnew) { const unsigned long long thr = pref << sh; stt[96 + qi] = 1u; stt[128 + qi] = (unsigned)thr; stt[160 + qi] = (unsigned)(thr >> 32); }
            }
        }
        __syncthreads();
        if (__all(stt[96 + q] != 0u)) break;
    }
    const unsigned long long thr = ((unsigned long long)stt[160 + q] << 32) | stt[128 + q];
#pragma unroll 1
    for (int s = wave; s < nsub; s += NWAVES) {
        const f32x16 isc = idx_tile(ikbase + (size_t)(32 * s) * LDP, qf, w);
        unsigned mb = 0u;
#pragma unroll
        for (int i = 0; i < 16; ++i) mb |= (comp_key(isc[i], 32 * s + crow(i, hi)) >= thr) ? (1u << crow(i, hi)) : 0u;
        mb |= (unsigned)__shfl_xor((int)mb, 32);
        if (hi == 0) mrow[s] = mb;
    }
    __syncthreads();
}

struct ProjOrder {
    pg8::StaticOrder so;
    __device__ void init(int G, int c) { so.init(MTOK, LDP, G, c); }
    __device__ bool next(int i, pg8::Unit& u) const {
        long L = (long)i * so.G + so.c;
        if (L < so.nwg) return so.next(i, u);
        L -= so.nwg; if (L >= 8) return false;
        u.pm = 32 + (int)(L >> 2); u.pn = 23 + (int)(L & 3); return true;
    }
    __device__ __forceinline__ void a_ready(const pg8::Unit&) const {}
    __device__ __forceinline__ void done(const pg8::Unit&) const {}
};

struct Args { const float* in[10]; float* out; unsigned char* ws; int ph_lo, ph_hi, li, pad; };
__global__ void __launch_bounds__(NWAVES * 64, 2) hyb_fwd(Args args) {
    extern __shared__ __attribute__((aligned(16))) unsigned char lds[];
    Frame F;
    F.lds = (LAS unsigned char*)lds;
    F.MISC = (volatile LAS unsigned*)(F.lds + MISC_OFF);
    F.tid = threadIdx.x; F.lane = F.tid & 63; F.wave = __builtin_amdgcn_readfirstlane(F.tid >> 6);
    F.G = gridDim.x; { const int bx = blockIdx.x; F.vcu = (F.G % 8 == 0) ? (bx % 8) * (F.G / 8) + bx / 8 : bx; }
    unsigned char* ws = args.ws;
    F.ctl = (gu32*)(ws + WS_CTL);
    F.x = args.in[0]; F.mem = args.in[1]; F.g_norm = args.in[2]; F.w_in = args.in[3]; F.sinks = args.in[4]; F.rel_bias = args.in[5];
    F.g_mem = args.in[6]; F.w_mem_kv = args.in[7]; F.w_out = args.in[8]; F.g_final = args.in[9]; F.out = args.out;
    F.WinT = (bf16*)(ws + WS_WINT); F.WmemT = (bf16*)(ws + WS_WMEMT); F.WoutT = (bf16*)(ws + WS_WOUTT); F.XN = (bf16*)(ws + WS_XN); F.MEMN = (bf16*)(ws + WS_MEMN);
    F.PROJ = (bf16*)(ws + WS_PROJ); F.MK = (bf16*)(ws + WS_MK); F.MVT = (bf16*)(ws + WS_MVT); F.AVT = (bf16*)(ws + WS_AVT); F.BVT = (bf16*)(ws + WS_BVT);
    F.Y = (bf16*)(ws + WS_Y); F.MASK = (unsigned*)(ws + WS_MASK); F.BIASA = (float*)(ws + WS_BIASA); F.BIASB = (float*)(ws + WS_BIASB); F.SSQ = (float*)(ws + WS_SSQ);
    for (int u = F.tid; u < (LDS_BYTES - LDSCTL_OFF) / 4; u += NWAVES * 64) ((LAS unsigned*)(F.lds + LDSCTL_OFF))[u] = 0u;
    __syncthreads();
    XcdBarrier bar; bar.bar = (unsigned*)(F.ctl + CW_BAR); bar.x = 0; bar.st = nullptr;
    if (N_LAUNCHES == 1) bar = xcd_barrier_post((unsigned*)(F.ctl + CW_BAR), F.MISC + 8);
#define GRID_BAR() do { if (N_LAUNCHES == 1) xcd_barrier(bar); } while (0)
    const int lo = args.ph_lo, hi = args.ph_hi;
#define IN(k) (lo <= (k) && (k) < hi)
#define BOTH(k) (IN(k) && IN((k) + 1))

    if (IN(0)) { p0_prologue(F); if (BOTH(0)) GRID_BAR(); }

    if (IN(1)) {
        pg8::Gemm g{F.XN, F.WinT, MTOK + MMEM, LDP + 1024, DM}; ProjOrder S; S.init(F.G, (int)blockIdx.x);
        pg8::EpiProj E{F.PROJ, F.AVT, F.BVT, F.MK, F.MVT};
        pg8::gemm_phase<pg8::EpiProj, ProjOrder, true, true>(F.lds + RING_OFF, g, S, E);
        if (BOTH(1)) GRID_BAR();
    }

    if (IN(2)) {
        for (;;) {
            if (F.tid == 0) F.MISC[0] = __hip_atomic_fetch_add(F.ctl + CW_Q, 1u, RLX_AGENT);
            __syncthreads();
            const int it = (int)F.MISC[0];
            __syncthreads();
            if (it >= 640) break;
            if (it < 256) sel_item(F, (it >> 1) & 1, 63 - (it >> 2), it & 1);
            else if (it < 512) { const int j = it - 256; aattn_item(F, j >> 7, (j >> 1) & 63, j & 1); }
            else { const int j = it - 512; cattn_item(F, j >> 6, j & 63); }
        }
        if (BOTH(2)) GRID_BAR();
    }

    if (IN(3)) {
        for (int k = F.vcu; k < 256; k += F.G) { const int hd = k & 3, b = (k >> 2) & 1, cp = k >> 3; battn_chunk(F, b, 63 - cp, hd); battn_chunk(F, b, cp, hd); }
        if (BOTH(3)) GRID_BAR();
    }

    if (IN(4)) {
        pg8::Gemm g{F.Y, F.WoutT, MTOK, DM, DM}; pg8::StaticOrder S; S.init(MTOK, DM, F.G, (int)blockIdx.x);
        pg8::EpiOut E{F.x, F.out, F.SSQ};
        pg8::gemm_phase<pg8::EpiOut, pg8::StaticOrder, true, true>(F.lds + RING_OFF, g, S, E);
        if (BOTH(4)) GRID_BAR();
    }

    if (IN(5)) {
        const int gw = F.vcu * NWAVES + F.wave, NGW = F.G * NWAVES;
        for (int m = gw; m < MTOK; m += NGW) {
            const float part = (F.lane < 32) ? F.SSQ[(size_t)m * 32 + F.lane] : 0.f;
            const float rstd = 1.f / sqrtf(wave_sum(part) * (1.f / DM) + EPS);
            GAS f32x4* o = (GAS f32x4*)(F.out + (size_t)m * DM) + F.lane; const GAS f32x4* gr = (const GAS f32x4*)F.g_final + F.lane;
#pragma unroll
            for (int j = 0; j < 8; ++j) { const f32x4 hv = o[64 * j], gv = gr[64 * j]; o[64 * j] = hv * rstd * gv; }
        }
    }
#undef IN
#undef BOTH
#undef GRID_BAR
}

extern "C" void kernel_launch(void* const* d_in, const int* in_sizes, int n_in, void* d_out, int out_size, void* d_ws, size_t ws_size, hipStream_t stream) {
    static int grid = 0;
    if (grid == 0) {
        if (n_in != 10 || in_sizes[0] != MTOK * DM || out_size != MTOK * DM || ws_size < WS_END) { fprintf(stderr, "kernel_launch: unexpected shapes (n_in %d, in0 %d, out %d, ws %zu); nothing launched\n", n_in, n_in > 0 ? in_sizes[0] : -1, out_size, ws_size); grid = -1; return; }
        int dev = 0, cus = 0, per_cu = 0;
        if (hipGetDevice(&dev) != hipSuccess || hipDeviceGetAttribute(&cus, hipDeviceAttributeMultiprocessorCount, dev) != hipSuccess) { fprintf(stderr, "kernel_launch: device query failed\n"); grid = -1; return; }
        if (hipFuncSetAttribute((const void*)hyb_fwd, hipFuncAttributeMaxDynamicSharedMemorySize, LDS_BYTES) != hipSuccess) { fprintf(stderr, "kernel_launch: hipFuncSetAttribute failed\n"); grid = -1; return; }
        if (hipOccupancyMaxActiveBlocksPerMultiprocessor(&per_cu, (const void*)hyb_fwd, NWAVES * 64, LDS_BYTES) != hipSuccess || per_cu < 1)
            fprintf(stderr, "kernel_launch: note: occupancy query reports %d workgroups per CU\n", per_cu);
        (void)hipGetLastError();
        grid = cus;
    }
    if (grid < 0) return;
    if (hipMemsetAsync((char*)d_ws + WS_CTL, 0, CTL_ZERO_BYTES, stream) != hipSuccess) { fprintf(stderr, "kernel_launch: hipMemsetAsync failed\n"); return; }
    Args a{};
    for (int i = 0; i < 10; ++i) a.in[i] = (const float*)d_in[i];
    a.out = (float*)d_out; a.ws = (unsigned char*)d_ws;
    for (int li = 0; li < N_LAUNCHES; ++li) {
        a.ph_lo = (N_LAUNCHES == N_PHASES) ? li : 0; a.ph_hi = (N_LAUNCHES == N_PHASES) ? li + 1 : N_PHASES; a.li = li;
        hipLaunchKernelGGL(hyb_fwd, dim3(grid), dim3(NWAVES * 64), LDS_BYTES, stream, a);
        const hipError_t le = hipPeekAtLastError();
        if (le != hipSuccess) { fprintf(stderr, "kernel_launch: launch %d failed: %s\n", li, hipGetErrorName(le)); break; }
    }
}
```

```cpp
#include <hip/hip_runtime.h>
#include <cstdio>
#include <cstdint>
#include <cmath>

namespace pg8 {
#define PG8_LAS __attribute__((address_space(3)))
typedef unsigned short bf16_t;
typedef short bf16x8 __attribute__((ext_vector_type(8)));
typedef float f32x4 __attribute__((ext_vector_type(4)));
typedef unsigned u32x4 __attribute__((ext_vector_type(4)));
constexpr int BM = 256, BK = 64, HALF = 128, HTB = HALF * BK * 2  , STAGE_BYTES = 8 * HTB, NXCD = 8, WGM = 8;

__host__ __device__ __forceinline__ int lds_byte(int r, int c) { const int st = (r >> 4) * 2 + (c >> 5), rr = r & 15, cc = c & 31, ob = rr * 64 + cc * 2; return st * 1024 + (ob ^ (((ob >> 9) & 1) << 5)); }
__host__ __device__ __forceinline__ void stage_rc(int b, int& R, int& C) { const int st = b / 1024, sb = b % 1024, swz = sb ^ (((sb >> 9) & 1) << 5); R = (st >> 1) * 16 + swz / 64; C = (st & 1) * 32 + (swz % 64) / 2; }
__host__ __device__ __forceinline__ int perm32(int rho) { const int n = rho >> 4, i = rho & 15; return 8 * (i >> 2) + 4 * n + (i & 3); }

struct Unit { int pm, pn; };
struct Gemm { const bf16_t* A; const bf16_t* Bt; int M, N, K; };

struct StaticOrder {
    int nM, nN, nwg, G, c;
    __host__ __device__ void init(int M, int N, int G_, int c_) { nM = M / BM; nN = N / BM; nwg = nM * nN; G = G_; c = c_; }
    __host__ __device__ bool next(int i, Unit& u) const {
        const long L = (long)i * G + c; if (L >= nwg) return false;
        int wgid = (int)L; { const int q = nwg / NXCD, r = nwg % NXCD, xcd = wgid % NXCD, off = wgid / NXCD; wgid = (xcd < r ? xcd * (q + 1) : r * (q + 1) + (xcd - r) * q) + off; }
        const int nig = WGM * nN, gid = wgid / nig, fm = gid * WGM, gsz = (nM - fm) < WGM ? (nM - fm) : WGM;
        u.pm = fm + ((wgid % nig) % gsz); u.pn = (wgid % nig) / gsz; return true;
    }
    __device__ __forceinline__ void a_ready(const Unit&) const {}
    __device__ __forceinline__ void done(const Unit&) const {}
};
__device__ __forceinline__ unsigned cvt_pk_bf16(float lo, float hi) { unsigned r; asm volatile("v_cvt_pk_bf16_f32 %0, %1, %2" : "=v"(r) : "v"(lo), "v"(hi)); return r; }
typedef unsigned u32x4_dummy_unused;

constexpr int LDP = 5888;
struct EpiProj {
    static constexpr bool PERM = true, AFTER_DRAIN = false;
    bf16_t* proj; bf16_t* mkv; bf16_t* ik;
    __device__ __forceinline__ static void st_row(bf16_t* p, const f32x4 v0, const f32x4 v1) {
        u32x4 w; w.x = cvt_pk_bf16(v0[0], v0[1]); w.y = cvt_pk_bf16(v0[2], v0[3]); w.z = cvt_pk_bf16(v1[0], v1[1]); w.w = cvt_pk_bf16(v1[2], v1[3]);
        *(u32x4*)p = w;
    }
    __device__ __forceinline__ void operator()(const f32x4 (&acc)[2][2][4][2], const Unit& u, int wr, int wc, int fr, int fq) const {
        const int rl0 = wr * 64 + fr, cl0 = wc * 32 + 8 * fq;
        bf16_t* base; int ld;
        if (u.pn < 23) { base = proj + (size_t)(u.pm * BM + rl0) * LDP + u.pn * BM + cl0; ld = LDP; }
        else { base = mkv + (size_t)((u.pm - 32) * BM + rl0) * 1024 + (u.pn - 23) * BM + cl0; ld = 1024; }
#pragma unroll
        for (int ai = 0; ai < 2; ++ai)
#pragma unroll
            for (int m = 0; m < 4; ++m) { bf16_t* rowp = base + (size_t)(ai * HALF + m * 16) * ld;
#pragma unroll
                for (int bj = 0; bj < 2; ++bj) st_row(rowp + bj * HALF, acc[ai][bj][m][0], acc[ai][bj][m][1]); }
        if (u.pn == 12 && cl0 < 64) {
#pragma unroll
            for (int ai = 0; ai < 2; ++ai)
#pragma unroll
                for (int m = 0; m < 4; ++m) st_row(ik + (size_t)(u.pm * BM + rl0 + ai * HALF + m * 16) * 64 + cl0, acc[ai][0][m][0], acc[ai][0][m][1]);
        }
    }
};
struct EpiOut {
    static constexpr bool PERM = false, AFTER_DRAIN = false;
    const float* x; float* out; float* ssq;
    __device__ __forceinline__ void operator()(const f32x4 (&acc)[2][2][4][2], const Unit& u, int wr, int wc, int fr, int fq) const {
        const int row0 = u.pm * BM + wr * 64 + fr, col0 = u.pn * BM + wc * 32 + 4 * fq;
#pragma unroll
        for (int ai = 0; ai < 2; ++ai)
#pragma unroll
            for (int m = 0; m < 4; ++m) { const int row = row0 + ai * HALF + m * 16; const size_t off = (size_t)row * 2048 + col0; float s = 0.f;
#pragma unroll
                for (int bj = 0; bj < 2; ++bj)
#pragma unroll
                    for (int n = 0; n < 2; ++n) { const f32x4 xv = *(const f32x4*)(x + off + bj * HALF + n * 16); const f32x4 hv = acc[ai][bj][m][n] + xv;
                        *(f32x4*)(out + off + bj * HALF + n * 16) = hv; s += (hv[0] * hv[0] + hv[1] * hv[1]) + (hv[2] * hv[2] + hv[3] * hv[3]); }
                s += __shfl_xor(s, 16); s += __shfl_xor(s, 32);
                if (fq == 0) ssq[(size_t)row * 32 + u.pn * 4 + wc] = s; }
    }
};
template <class Epi, class Sched, bool ALIGN_EPI = false, bool SP2 = false>
__device__ __forceinline__ void gemm_phase(PG8_LAS unsigned char* lds, const Gemm g, const Sched& S, const Epi& E) {
    const int tid = threadIdx.x, wid = __builtin_amdgcn_readfirstlane(tid >> 6), lane = tid & 63, wr = wid >> 2, wc = wid & 3, fr = lane & 15, fq = lane >> 4;
    const int K = g.K, nt = K / BK;
    unsigned voffA[2], voffB[2];
#pragma unroll
    for (int i = 0; i < 2; ++i) { int R, C; stage_rc(tid * 16 + i * 8192, R, C); const int Rb = Epi::PERM ? ((R & ~31) + perm32(R & 31)) : R;
        voffA[i] = (unsigned)(R * K + C) * 2u; voffB[i] = (unsigned)(Rb * K + C) * 2u; }
    const size_t kstep = (size_t)(BK * 2);
    const size_t hstep = (size_t)HALF * K * 2;
    const size_t tstep = 2 * hstep;
    const unsigned ldsw = (unsigned)wid * 1024u;
    const int aoff = lds_byte(wr * 64 + fr, fq * 8), boff = lds_byte(wc * 32 + fr, fq * 8);
#define PG8_SA(b, h) (((b) * 2 + (h)) * HTB)
#define PG8_SB(b, h) ((4 + (b) * 2 + (h)) * HTB)
#define PG8_STAGE(bufoff, gbase, voff) do { _Pragma("unroll") for (int _i = 0; _i < 2; ++_i) \
        __builtin_amdgcn_global_load_lds((const unsigned*)((const char*)(gbase) + (voff)[_i]), (PG8_LAS unsigned*)(lds + (bufoff) + ldsw + _i * 8192), 16, 0, 0); } while (0)
#define PG8_LDA(dst, b, h) do { _Pragma("unroll") for (int m = 0; m < 4; ++m) _Pragma("unroll") for (int k = 0; k < 2; ++k) dst[m][k] = *(const PG8_LAS bf16x8*)(lds + PG8_SA(b, h) + aoff + m * 2048 + k * 1024); } while (0)
#define PG8_LDB(dst, b, h) do { _Pragma("unroll") for (int n = 0; n < 2; ++n) _Pragma("unroll") for (int k = 0; k < 2; ++k) dst[n][k] = *(const PG8_LAS bf16x8*)(lds + PG8_SB(b, h) + boff + n * 2048 + k * 1024); } while (0)
#define PG8_MMA(ai, bj, At, Bt) do { __builtin_amdgcn_s_setprio(1); _Pragma("unroll") for (int m = 0; m < 4; ++m) _Pragma("unroll") for (int n = 0; n < 2; ++n) _Pragma("unroll") for (int k = 0; k < 2; ++k) \
        acc[ai][bj][m][n] = __builtin_amdgcn_mfma_f32_16x16x32_bf16(Bt[n][k], At[m][k], acc[ai][bj][m][n], 0, 0, 0); __builtin_amdgcn_s_setprio(0); } while (0)
#define PG8_WAIT_V(n) asm volatile("s_waitcnt vmcnt(" #n ")" ::: "memory")
#define PG8_WAIT_L(n) asm volatile("s_waitcnt lgkmcnt(" #n ")" ::: "memory")
#define PG8_BAR __builtin_amdgcn_s_barrier()
#define PG8_SCHED __builtin_amdgcn_sched_barrier(0)
    Unit cur, nxt; int ui = 0;
    if (!S.next(0, cur)) return;
    f32x4 acc[2][2][4][2];
#pragma unroll
    for (int a = 0; a < 2; ++a)
#pragma unroll
        for (int b = 0; b < 2; ++b)
#pragma unroll
            for (int m = 0; m < 4; ++m)
#pragma unroll
                for (int n = 0; n < 2; ++n) acc[a][b][m][n] = (f32x4){0.f, 0.f, 0.f, 0.f};
    bf16x8 At[4][2], B0[2][2], B1[2][2];
    const char* cA = (const char*)g.A + (size_t)cur.pm * tstep; const char* cB = (const char*)g.Bt + (size_t)cur.pn * tstep;
    S.a_ready(cur);
    if constexpr (SP2) {
        PG8_STAGE(PG8_SB(0, 0), cB, voffB); PG8_STAGE(PG8_SB(0, 1), cB + hstep, voffB); PG8_STAGE(PG8_SA(0, 0), cA, voffA); PG8_STAGE(PG8_SA(0, 1), cA + hstep, voffA);
        if (wr == 1) PG8_BAR;
        PG8_WAIT_V(2); PG8_BAR;
        PG8_STAGE(PG8_SB(1, 0), cB + kstep, voffB); PG8_STAGE(PG8_SA(1, 0), cA + kstep, voffA); PG8_STAGE(PG8_SB(1, 1), cB + hstep + kstep, voffB);
        PG8_WAIT_V(6); PG8_BAR;
    } else {
        PG8_STAGE(PG8_SB(0, 0), cB, voffB); PG8_STAGE(PG8_SA(0, 0), cA, voffA); PG8_STAGE(PG8_SB(0, 1), cB + hstep, voffB); PG8_STAGE(PG8_SA(0, 1), cA + hstep, voffA);
        if (wr == 1) PG8_BAR;
        PG8_WAIT_V(4); PG8_BAR;
        PG8_STAGE(PG8_SB(1, 0), cB + kstep, voffB); PG8_STAGE(PG8_SA(1, 0), cA + kstep, voffA); PG8_STAGE(PG8_SB(1, 1), cB + hstep + kstep, voffB);
        PG8_WAIT_V(6); PG8_BAR;
    }
    for (;;) {
        const bool has_next = S.next(ui + 1, nxt);
        const char* nA = has_next ? (const char*)g.A + (size_t)nxt.pm * tstep : cA; const char* nB = has_next ? (const char*)g.Bt + (size_t)nxt.pn * tstep : cB;
        for (int t = 0; t < nt; t += 2) {
            const bool last = (t == nt - 2);
            const char* a1 = cA + (size_t)(t + 1) * kstep;
            const char* a2 = last ? nA : cA + (size_t)(t + 2) * kstep; const char* b2 = last ? nB : cB + (size_t)(t + 2) * kstep;
            const char* a3 = a2 + kstep; const char* b3 = b2 + kstep;
            if (last && has_next) S.a_ready(nxt);
            if constexpr (SP2) {
            PG8_LDB(B0, 0, 0); PG8_LDB(B1, 0, 1); PG8_SCHED; PG8_LDA(At, 0, 0); PG8_STAGE(PG8_SA(1, 1), a1 + hstep, voffA);
            PG8_WAIT_V(8); PG8_WAIT_L(0); PG8_BAR; PG8_MMA(0, 0, At, B0); PG8_MMA(0, 1, At, B1); PG8_BAR; PG8_SCHED;
            PG8_LDA(At, 0, 1); PG8_STAGE(PG8_SB(0, 0), b2, voffB); PG8_STAGE(PG8_SB(0, 1), b2 + hstep, voffB); PG8_STAGE(PG8_SA(0, 0), a2, voffA);
            PG8_WAIT_V(8); PG8_WAIT_L(0); PG8_BAR; PG8_MMA(1, 0, At, B0); PG8_MMA(1, 1, At, B1); PG8_BAR; PG8_SCHED;
            PG8_LDB(B0, 1, 0); PG8_LDB(B1, 1, 1); PG8_SCHED; PG8_LDA(At, 1, 0); PG8_STAGE(PG8_SA(0, 1), a2 + hstep, voffA);
            PG8_WAIT_V(8); PG8_WAIT_L(0); PG8_BAR; PG8_MMA(0, 0, At, B0); PG8_MMA(0, 1, At, B1); PG8_BAR; PG8_SCHED;
            PG8_LDA(At, 1, 1); PG8_STAGE(PG8_SB(1, 0), b3, voffB); PG8_STAGE(PG8_SB(1, 1), b3 + hstep, voffB); PG8_STAGE(PG8_SA(1, 0), a3, voffA);
            PG8_WAIT_V(8); PG8_WAIT_L(0); PG8_BAR; PG8_MMA(1, 0, At, B0); PG8_MMA(1, 1, At, B1); PG8_BAR; PG8_SCHED;
            } else {
            PG8_LDB(B0, 0, 0); PG8_SCHED; PG8_LDA(At, 0, 0); PG8_STAGE(PG8_SA(1, 1), a1 + hstep, voffA);
            PG8_WAIT_L(8); PG8_BAR; PG8_WAIT_L(0); PG8_MMA(0, 0, At, B0); PG8_BAR; PG8_SCHED;
            PG8_LDB(B1, 0, 1); PG8_STAGE(PG8_SB(0, 0), b2, voffB);
            PG8_BAR; PG8_WAIT_L(0); PG8_MMA(0, 1, At, B1); PG8_BAR;
            PG8_LDA(At, 0, 1); PG8_STAGE(PG8_SA(0, 0), a2, voffA);
            PG8_BAR; PG8_WAIT_L(0); PG8_MMA(1, 0, At, B0); PG8_BAR; PG8_SCHED;
            PG8_STAGE(PG8_SB(0, 1), b2 + hstep, voffB);
            PG8_WAIT_V(6); PG8_BAR; PG8_MMA(1, 1, At, B1); PG8_BAR;
            PG8_LDB(B0, 1, 0); PG8_SCHED; PG8_LDA(At, 1, 0); PG8_STAGE(PG8_SA(0, 1), a2 + hstep, voffA);
            PG8_WAIT_L(8); PG8_BAR; PG8_WAIT_L(0); PG8_MMA(0, 0, At, B0); PG8_BAR; PG8_SCHED;
            PG8_LDB(B1, 1, 1); PG8_STAGE(PG8_SB(1, 0), b3, voffB);
            PG8_BAR; PG8_WAIT_L(0); PG8_MMA(0, 1, At, B1); PG8_BAR;
            PG8_LDA(At, 1, 1); PG8_STAGE(PG8_SA(1, 0), a3, voffA);
            PG8_BAR; PG8_WAIT_L(0); PG8_MMA(1, 0, At, B0); PG8_BAR; PG8_SCHED;
            PG8_STAGE(PG8_SB(1, 1), b3 + hstep, voffB);
            PG8_WAIT_V(6); PG8_BAR; PG8_MMA(1, 1, At, B1); PG8_BAR;
            }
        }
        if constexpr (ALIGN_EPI) { if (wr == 0) PG8_BAR; }
        if constexpr (!Epi::AFTER_DRAIN) { E(acc, cur, wr, wc, fr, fq); S.done(cur); }
        if (!has_next) break;
#pragma unroll
        for (int a = 0; a < 2; ++a)
#pragma unroll
            for (int b = 0; b < 2; ++b)
#pragma unroll
                for (int m = 0; m < 4; ++m)
#pragma unroll
                    for (int n = 0; n < 2; ++n) acc[a][b][m][n] = (f32x4){0.f, 0.f, 0.f, 0.f};
        cur = nxt; cA = nA; cB = nB; ++ui;
        if constexpr (ALIGN_EPI) { if (wr == 1) PG8_BAR; }
    }
    PG8_WAIT_V(0);
    if constexpr (!ALIGN_EPI) { if (wr == 0) PG8_BAR; }
    PG8_BAR;
    if constexpr (Epi::AFTER_DRAIN) { E.fused(acc, cur, wr, wc, fr, fq, lds, wid, lane); S.done(cur); }
#undef PG8_SA
#undef PG8_SB
#undef PG8_STAGE
#undef PG8_LDA
#undef PG8_LDB
#undef PG8_MMA
#undef PG8_WAIT_V
#undef PG8_WAIT_L
#undef PG8_BAR
#undef PG8_SCHED
}
}
#define GAS __attribute__((address_space(1)))
#define LAS __attribute__((address_space(3)))
typedef unsigned short bf16;
typedef unsigned v4u __attribute__((ext_vector_type(4)));
typedef float f32x4 __attribute__((ext_vector_type(4)));
typedef short bf16x8 __attribute__((ext_vector_type(8)));
typedef GAS unsigned gu32;
typedef GAS unsigned long long gu64;
#define RLX_AGENT __ATOMIC_RELAXED, __HIP_MEMORY_SCOPE_AGENT
#define LDS_WAIT() asm volatile("s_waitcnt lgkmcnt(0)" ::: "memory")
#define VM_WAIT() asm volatile("s_waitcnt vmcnt(0)" ::: "memory")
__device__ __forceinline__ unsigned long long rt() { return __builtin_amdgcn_s_memrealtime(); }
__device__ __forceinline__ unsigned f2bf(float f) { unsigned u = __builtin_bit_cast(unsigned, f); return (u + 0x7fffu + ((u >> 16) & 1u)) >> 16; }
__device__ __forceinline__ unsigned pk2(float lo, float hi) { return f2bf(lo) | (f2bf(hi) << 16); }
#define XB_TMO      128
#define XB_XCNT(j)  (256  + 64 * (j))
#define XB_XSUB(j)  (1280 + 64 * (j))
#define XB_XGEN(j)  (2304 + 64 * (j))
#define XB_TOP      3328
#define XB_TOPGEN   3392
#define XCD_BAR_WORDS 3456
#define XB_SPIN_CAP (1u << 18)

__device__ __forceinline__ unsigned xb_ld(unsigned* p)              { return __hip_atomic_load(p, __ATOMIC_RELAXED, __HIP_MEMORY_SCOPE_AGENT); }
__device__ __forceinline__ unsigned xb_add(unsigned* p, unsigned v) { return __hip_atomic_fetch_add(p, v, __ATOMIC_RELAXED, __HIP_MEMORY_SCOPE_AGENT); }
__device__ __forceinline__ unsigned xb_xcc_id() { return (unsigned)__builtin_amdgcn_s_getreg((3 << 11) | 20) & 0xFu; }
#define XB_SPIN(cond, bar) do { unsigned _sp = 0; while (cond) { __builtin_amdgcn_s_sleep(1); \
    if ((++_sp & 255u) == 0u) { if (xb_ld(&(bar)[XB_TMO])) break; if (_sp > XB_SPIN_CAP) { atomicAdd(&(bar)[XB_TMO], 1u); break; } } } } while (0)

struct XcdBarrier {
    unsigned* bar; unsigned x;
    volatile LAS unsigned* st;
};

__device__ __forceinline__ XcdBarrier xcd_barrier_post(unsigned* bar, volatile LAS unsigned* st) {
    XcdBarrier b; b.bar = bar; b.x = xb_xcc_id(); b.st = st;
    if (threadIdx.x == 0) (void)xb_add(&bar[XB_XCNT(b.x)], 1u);
    return b;
}
__device__ __forceinline__ void xcd_barrier_complete(unsigned* bar, unsigned x, unsigned& nloc, unsigned& nx) {
    const unsigned G = gridDim.x * gridDim.y * gridDim.z;
    unsigned sum, cnt, mine, sp = 0u;
    for (;;) {
        sum = 0u; cnt = 0u; mine = 0u;
#pragma unroll
        for (unsigned j = 0; j < 16; ++j) { const unsigned c = xb_ld(&bar[XB_XCNT(j)]); sum += c; cnt += (c > 0u) ? 1u : 0u; mine = (j == x) ? c : mine; }
        if (sum == G) break;
        __builtin_amdgcn_s_sleep(1);
        if ((++sp & 255u) == 0u) { if (xb_ld(&bar[XB_TMO])) break; if (sp > XB_SPIN_CAP) { atomicAdd(&bar[XB_TMO], 1u); break; } }
    }
    nloc = mine > 0u ? mine : 1u; nx = cnt > 0u ? cnt : 1u;
}

__device__ __forceinline__ void xcd_barrier(const XcdBarrier& b) {
    asm volatile("s_waitcnt vmcnt(0)" ::: "memory");
    __syncthreads();
    if (threadIdx.x == 0) {
        unsigned* bar = b.bar;
        __builtin_amdgcn_s_waitcnt(0);
        unsigned nloc = b.st[0], nx = b.st[1];
        if (nloc == 0u) { xcd_barrier_complete(bar, b.x, nloc, nx); b.st[0] = nloc; b.st[1] = nx; }
        const unsigned old = xb_add(&bar[XB_XSUB(b.x)], 1u);
        const unsigned gen = old / nloc;
        if (old + 1u == (gen + 1u) * nloc) {
            __builtin_amdgcn_fence(__ATOMIC_RELEASE, "agent");
            asm volatile("s_waitcnt vmcnt(0)" ::: "memory");
            const unsigned og = xb_add(&bar[XB_TOP], 1u);
            const unsigned tg = og / nx;
            if (og + 1u == (tg + 1u) * nx) xb_add(&bar[XB_TOPGEN], 1u);
            else XB_SPIN(xb_ld(&bar[XB_TOPGEN]) == tg, bar);
            __builtin_amdgcn_fence(__ATOMIC_ACQUIRE, "agent");
            xb_add(&bar[XB_XGEN(b.x)], 1u);
            asm volatile("s_waitcnt vmcnt(0)" ::: "memory");
        } else {
            XB_SPIN(xb_ld(&bar[XB_XGEN(b.x)]) == gen, bar);
            __builtin_amdgcn_fence(__ATOMIC_ACQUIRE, "agent");
            asm volatile("s_waitcnt vmcnt(0)" ::: "memory");
        }
    }
    __syncthreads();
}

constexpr int NWAVES = 8;
constexpr int NB = 2, SEQ = 4096, DM = 2048, MTOK = NB * SEQ, NMEM = 256, MMEM = NB * NMEM;
constexpr int LDP = pg8::LDP, NSRC = 5700;
constexpr int C_AQ = 0, C_AK = 1024, C_AV = 1152, C_BQ = 1280, C_BK = 1792, C_BV = 2304, C_IQ = 2816, C_IK = 3072, C_IW = 3136, C_CQ = 3328, C_GATE = 3840;
constexpr float EPS = 1e-6f, LOG2E = 1.4426950408889634f;
constexpr int NBH = 20;
constexpr int BIASB_N = 4160;
#ifndef MK_N_LAUNCHES
#define MK_N_LAUNCHES 1
#endif
constexpr int N_LAUNCHES = MK_N_LAUNCHES;
constexpr int N_PHASES = 6;

constexpr size_t MiB = 1u << 20;
constexpr size_t WS_CTL = 0, CTL_ZERO_BYTES = 1 * MiB;
constexpr size_t WS_WINT = 2 * MiB;
constexpr size_t WS_WMEMT = 25 * MiB;
constexpr size_t WS_WOUTT = 29 * MiB;
constexpr size_t WS_XN = 38 * MiB;
constexpr size_t WS_MEMN = 70 * MiB;
constexpr size_t WS_PROJ = 72 * MiB;
constexpr size_t WS_MKV = 164 * MiB;
constexpr size_t WS_IK = 166 * MiB;
constexpr size_t WS_MASK = 175 * MiB;
constexpr size_t WS_BIASA = 179 * MiB;
constexpr size_t WS_BIASB = 180 * MiB;
constexpr size_t WS_Y = 181 * MiB;
constexpr size_t WS_SSQ = 213 * MiB;
constexpr size_t WS_END = 214 * MiB;
static_assert(WS_WINT + (size_t)5888 * 2048 * 2 == WS_WMEMT && WS_XN + (size_t)MTOK * DM * 2 == WS_MEMN && WS_PROJ + (size_t)MTOK * LDP * 2 <= WS_MKV, "d_ws map");
constexpr int CW_TMO = 0, CW_CODE = 1, CW_BAR = 4096, CW_Q = 8192;

constexpr int RING_OFF = 0, RING_BYTES = 131072;
constexpr int LDSCTL_OFF = 139264, MISC_OFF = LDSCTL_OFF + 320;
constexpr int LDS_BYTES = 147456;
static_assert(8 * 16896 <= LDSCTL_OFF && MISC_OFF + 128 <= LDS_BYTES, "LDS map");

typedef float f32x16 __attribute__((ext_vector_type(16)));
typedef unsigned u32x2 __attribute__((ext_vector_type(2)));
typedef float f32x2_t __attribute__((ext_vector_type(2)));
typedef __bf16 bf16x2_t __attribute__((ext_vector_type(2)));
#define DI __device__ __forceinline__
#define MFMA32(a, b, c) __builtin_amdgcn_mfma_f32_32x32x16_bf16((a), (b), (c), 0, 0, 0)
DI int crow(int r, int hi) { return (r & 3) + 8 * (r >> 2) + 4 * hi; }
DI float bf2f(unsigned v) { return __uint_as_float(v << 16); }
DI unsigned cvtpk(float lo, float hi) { f32x2_t v = {lo, hi}; bf16x2_t b = __builtin_convertvector(v, bf16x2_t); return __builtin_bit_cast(unsigned, b); }
DI float ex2(float v) { return __builtin_amdgcn_exp2f(v); }
DI float wave_sum(float v) {
#pragma unroll
    for (int o = 1; o < 64; o <<= 1) v += __shfl_xor(v, o);
    return v;
}

struct Frame {
    LAS unsigned char* lds;
    volatile LAS unsigned* MISC;
    gu32* ctl;
    int tid, lane, wave, vcu, G;
    unsigned long long pacc;
    const float *x, *mem, *g_norm, *w_in, *sinks, *rel_bias, *g_mem, *w_mem_kv, *w_out, *g_final; float* out;
    bf16 *WinT, *WmemT, *WoutT, *XN, *MEMN, *PROJ, *MKV, *IK, *Y; unsigned* MASK; float *BIASA, *BIASB, *SSQ;
};

DI void p0_transpose_item(const float* W, int Nsrc, int K, bf16* WT, int mode, LAS float* scr, int item, int nblk, int lane) {
    const int kb = item / nblk, nb = item % nblk, k0 = 64 * kb, n0 = 64 * nb;
    const int nn = n0 + 4 * (lane & 15);
    int sc = nn; if (mode == 1) sc = nn < 3140 ? nn : (nn < 3328 ? -1 : nn - 188);
    const float msk = sc >= 0 ? 1.f : 0.f; const int scc = sc >= 0 ? sc : 0;
    const GAS float* src = (const GAS float*)W + (size_t)(k0 + (lane >> 4)) * Nsrc + scc;
    f32x4 v[16];
#pragma unroll
    for (int i = 0; i < 16; ++i) v[i] = *(const GAS f32x4*)(src + (size_t)(4 * i) * Nsrc);
#pragma unroll
    for (int i = 0; i < 16; ++i) { LAS float* d = scr + (4 * i + (lane >> 4)) * 65 + 4 * (lane & 15); d[0] = v[i].x * msk; d[1] = v[i].y * msk; d[2] = v[i].z * msk; d[3] = v[i].w * msk; }
    LDS_WAIT(); asm volatile("" ::: "memory");
    const int c = lane & 7;
#pragma unroll
    for (int j = 0; j < 8; ++j) { const int n = (lane >> 3) + 8 * j; const LAS float* s = scr + (8 * c) * 65 + n;
        v4u o; o.x = pk2(s[0 * 65], s[1 * 65]); o.y = pk2(s[2 * 65], s[3 * 65]); o.z = pk2(s[4 * 65], s[5 * 65]); o.w = pk2(s[6 * 65], s[7 * 65]);
        *(GAS v4u*)(WT + (size_t)(n0 + n) * K + k0 + 8 * c) = o; }
    LDS_WAIT(); asm volatile("" ::: "memory");
}
DI void rms_row_to_bf16(const float* xrow, const float* g, bf16* orow, int lane) {
    const GAS f32x4* xr = (const GAS f32x4*)xrow + lane; const GAS f32x4* gr = (const GAS f32x4*)g + lane;
    f32x4 v[8]; float s = 0.f;
#pragma unroll
    for (int j = 0; j < 8; ++j) { v[j] = xr[64 * j]; s += (v[j].x * v[j].x + v[j].y * v[j].y) + (v[j].z * v[j].z + v[j].w * v[j].w); }
    const float rstd = 1.f / sqrtf(wave_sum(s) * (1.f / DM) + EPS);
    GAS unsigned long long* o8 = (GAS unsigned long long*)orow + lane;
#pragma unroll
    for (int j = 0; j < 8; ++j) { const f32x4 gv = gr[64 * j];
        o8[64 * j] = (unsigned long long)pk2(v[j].x * rstd * gv.x, v[j].y * rstd * gv.y) | ((unsigned long long)pk2(v[j].z * rstd * gv.z, v[j].w * rstd * gv.w) << 32); }
}
DI int t5_bucket(int rel) {
    const int n = rel < 0 ? -rel : rel; int b = n;
    if (n >= 8) b = 8 + (n >= 15) + (n >= 27) + (n >= 50) + (n >= 91) + (n >= 166) + (n >= 305) + (n >= 559);
    return b + (rel > 0 ? 16 : 0);
}
DI void p0_prologue(Frame& F) {
    LAS float* scr = (LAS float*)(F.lds + RING_OFF + F.wave * 16896);
    const int gw = F.vcu * NWAVES + F.wave, NGW = F.G * NWAVES;
    constexpr int I_IN = 32 * 92, I_OUT = 32 * 32, I_MEM = 32 * 16, NITEMS = I_IN + I_OUT + I_MEM;
    for (int it = gw; it < NITEMS; it += NGW) {
        int r = it;
        if (r < I_IN) { p0_transpose_item(F.w_in, NSRC, DM, F.WinT, 1, scr, r, 92, F.lane); continue; } r -= I_IN;
        if (r < I_OUT) { p0_transpose_item(F.w_out, DM, DM, F.WoutT, 0, scr, r, 32, F.lane); continue; } r -= I_OUT;
        p0_transpose_item(F.w_mem_kv, 1024, DM, F.WmemT, 0, scr, r, 16, F.lane);
    }
    for (int m = gw; m < MTOK + MMEM; m += NGW) {
        if (m < MTOK) rms_row_to_bf16(F.x + (size_t)m * DM, F.g_norm, F.XN + (size_t)m * DM, F.lane);
        else rms_row_to_bf16(F.mem + (size_t)(m - MTOK) * DM, F.g_mem, F.MEMN + (size_t)(m - MTOK) * DM, F.lane);
    }
    const int gt = (int)blockIdx.x * (NWAVES * 64) + F.tid, NGT = F.G * NWAVES * 64;
    for (int i = gt; i < 16 * 64 * 192 + 4 * BIASB_N; i += NGT) {
        if (i < 16 * 64 * 192) { const int a = i / (64 * 192), r2 = i % (64 * 192), qi = r2 / 192, kj = r2 % 192;
            F.BIASA[i] = F.rel_bias[t5_bucket(kj - 128 - qi) * NBH + a] * LOG2E; }
        else { const int j = i - 16 * 64 * 192, hd = j / BIASB_N, e = j % BIASB_N;
            F.BIASB[j] = F.rel_bias[t5_bucket(e - 4095) * NBH + 16 + hd] * LOG2E; }
    }
}

template <int HD> struct ASt { f32x16 o[HD / 32]; float m, l; };
template <int HD> DI void ast_init(ASt<HD>& st) {
#pragma unroll
    for (int dt = 0; dt < HD / 32; ++dt)
#pragma unroll
        for (int i = 0; i < 16; ++i) st.o[dt][i] = 0.f;
    st.m = -INFINITY; st.l = 0.f;
}
template <int HD> DI void attn_store(const ASt<HD>& st, const float inv, const bf16* gate_row, bf16* yrow, const int hi) {
#pragma unroll
    for (int dt = 0; dt < HD / 32; ++dt)
#pragma unroll
        for (int g4 = 0; g4 < 4; ++g4) {
            const int d = 32 * dt + 8 * g4 + 4 * hi;
            const u32x2 gv = *(const GAS u32x2*)(gate_row + d);
            float gg[4] = {bf2f(gv.x & 0xffffu), bf2f(gv.x >> 16), bf2f(gv.y & 0xffffu), bf2f(gv.y >> 16)}, yv[4];
#pragma unroll
            for (int j = 0; j < 4; ++j) { const float sg = gg[j] / (1.f + ex2(-gg[j] * LOG2E)); yv[j] = st.o[dt][4 * g4 + j] * inv * sg; }
            u32x2 w; w.x = cvtpk(yv[0], yv[1]); w.y = cvtpk(yv[2], yv[3]);
            *(GAS u32x2*)(yrow + d) = w;
        }
}

DI unsigned off_b(unsigned row, unsigned ch) { return 256u * row + 16u * (ch ^ (((row & 3u) << 2) | ((row >> 2) & 3u))); }
typedef short v4i16_t __attribute__((ext_vector_type(4)));
DI v4i16_t vtr(const LAS unsigned char* p) { return __builtin_amdgcn_ds_read_tr16_b64_v4i16((LAS v4i16_t*)p); }
template <int HD> DI void softmax_upd(ASt<HD>& st, f32x16& x, bf16x8& pf0, bf16x8& pf1) {
    float m0 = fmaxf(fmaxf(x[0], x[1]), fmaxf(x[2], x[3])), m1 = fmaxf(fmaxf(x[4], x[5]), fmaxf(x[6], x[7]));
    float m2 = fmaxf(fmaxf(x[8], x[9]), fmaxf(x[10], x[11])), m3 = fmaxf(fmaxf(x[12], x[13]), fmaxf(x[14], x[15]));
    float mx = fmaxf(fmaxf(m0, m1), fmaxf(m2, m3));
    mx = fmaxf(mx, __shfl_xor(mx, 32));
    const float mnew = fmaxf(st.m, mx);
    const float muse = (mnew == -INFINITY) ? 0.f : mnew;
    if (__any(mnew != st.m)) {
        const float alpha = ex2(st.m - muse);
        st.l *= alpha;
#pragma unroll
        for (int dt = 0; dt < HD / 32; ++dt)
#pragma unroll
            for (int i = 0; i < 16; ++i) st.o[dt][i] *= alpha;
        st.m = mnew;
    }
    float ps = 0.f;
#pragma unroll
    for (int i = 0; i < 16; ++i) { x[i] = ex2(x[i] - muse); ps += x[i]; }
    st.l += ps;
    v4u pw; pw.x = cvtpk(x[0], x[1]); pw.y = cvtpk(x[2], x[3]); pw.z = cvtpk(x[4], x[5]); pw.w = cvtpk(x[6], x[7]);
    pf0 = __builtin_bit_cast(bf16x8, pw);
    pw.x = cvtpk(x[8], x[9]); pw.y = cvtpk(x[10], x[11]); pw.z = cvtpk(x[12], x[13]); pw.w = cvtpk(x[14], x[15]);
    pf1 = __builtin_bit_cast(bf16x8, pw);
}
DI void battn_chunk(Frame& F, const int b, const int c, const int hd) {
    int tid = F.tid; asm volatile("" : "+v"(tid));
    const int lane = tid & 63, q = lane & 31, hi = lane >> 5, g = F.wave & 1, sub = F.wave >> 1;
    const int qin = c * 64 + g * 32 + q; const size_t row = (size_t)b * SEQ + qin;
    const float c1 = 0.08838834764831845f * LOG2E;
    bf16x8 qf[8];
#pragma unroll
    for (int ks = 0; ks < 8; ++ks) qf[ks] = *(const GAS bf16x8*)(F.PROJ + row * LDP + C_BQ + hd * 128 + 16 * ks + 8 * hi);
    ASt<128> st; ast_init(st);
    const unsigned* mrow = F.MASK + row * 128;
    const float* btab = F.BIASB + hd * BIASB_N + 4095 - qin;
    const float bfar = F.rel_bias[15 * NBH + 16 + hd] * LOG2E;
    const int nkeys = 64 * (c + 1), nsteps = (c + 2) >> 1;
    const bf16* ksrc = F.PROJ + ((size_t)b * SEQ + (tid >> 4)) * LDP + C_BK + hd * 128 + 8 * (tid & 15);
    const bf16* vsrc = ksrc + (C_BV - C_BK);
    unsigned doff[4];
#pragma unroll
    for (int i = 0; i < 4; ++i) doff[i] = off_b((unsigned)((tid >> 4) + 32 * i), (unsigned)(tid & 15));
    LAS unsigned char* const lds = F.lds + RING_OFF;
    v4u sr[4];
#define BA_LOAD(src, step) do { _Pragma("unroll") for (int i_ = 0; i_ < 4; ++i_) sr[i_] = *(const GAS v4u*)((src) + ((size_t)(step) * 128 + 32 * i_) * LDP); } while (0)
#define BA_WRITE(imgoff) do { _Pragma("unroll") for (int i_ = 0; i_ < 4; ++i_) *(LAS v4u*)(lds + (imgoff) + doff[i_]) = sr[i_]; } while (0)
    BA_LOAD(ksrc, 0); BA_WRITE(0); BA_LOAD(vsrc, 0); BA_WRITE(32768);
    __syncthreads();
    const unsigned rl = (unsigned)(sub * 32 + q);
    const unsigned kx = ((rl & 3u) << 2) | ((rl >> 2) & 3u);
    const unsigned kbase0 = 256u * rl + 16u * ((unsigned)hi ^ (kx & 1u));
    const unsigned qq = (unsigned)((lane & 15) >> 2), p4 = (unsigned)(lane & 3), blk = (unsigned)((lane >> 4) & 1);
    const unsigned vrow = (unsigned)(sub * 32 + 4 * hi) + qq;
    const unsigned vlow = 2u * blk + (p4 >> 1);
    const unsigned vbase0 = 256u * vrow + 16u * (vlow ^ ((unsigned)hi & 3u)) + 8u * (p4 & 1u);
    const unsigned vbase1 = 256u * (vrow + 8u) + 16u * (vlow ^ ((2u + (unsigned)hi) & 3u)) + 8u * (p4 & 1u);
#pragma unroll 1
    for (int step = 0; step < nsteps; ++step) {
        const bool more = step + 1 < nsteps, valid = step * 128 + sub * 32 < nkeys;
        if (more) BA_LOAD(ksrc, step + 1);
        const int key0 = step * 128 + sub * 32;
        bf16x8 pf[2];
        if (valid) {
            const LAS unsigned char* kimg = lds + (step & 1) * 65536;
            const unsigned mb = *(const GAS unsigned*)(mrow + (key0 >> 5));
            unsigned kxh = kx >> 1; asm volatile("" : "+v"(kxh));
            f32x16 x;
#pragma unroll
            for (int i = 0; i < 16; ++i) x[i] = 0.f;
#pragma unroll
            for (int ks = 0; ks < 8; ++ks) { const bf16x8 a = *(const LAS bf16x8*)(kimg + kbase0 + 32u * ((unsigned)ks ^ kxh)); x = MFMA32(a, qf[ks], x); }
            if ((c * 64 + g * 32) - (key0 + 31) >= 559) {
#pragma unroll
                for (int i = 0; i < 16; ++i) x[i] = ((mb >> crow(i, hi)) & 1u) ? fmaf(x[i], c1, bfar) : -INFINITY;
            } else {
                const GAS float* bp = (const GAS float*)(btab + key0 + 4 * hi);
#pragma unroll
                for (int i = 0; i < 16; ++i) { const float bias = bp[(i & 3) + 8 * (i >> 2)]; x[i] = ((mb >> crow(i, hi)) & 1u) ? fmaf(x[i], c1, bias) : -INFINITY; }
            }
            softmax_upd<128>(st, x, pf[0], pf[1]);
        }
        if (more) { BA_WRITE(((step + 1) & 1) * 65536); BA_LOAD(vsrc, step + 1); }
        if (valid) {
            const LAS unsigned char* vimg = lds + (step & 1) * 65536 + 32768;
            unsigned qv = qq; asm volatile("" : "+v"(qv));
#pragma unroll
            for (int dt = 0; dt < 4; ++dt) {
                const unsigned xo = 64u * ((unsigned)dt ^ qv);
#pragma unroll
                for (int kk = 0; kk < 2; ++kk) {
                    const v4i16_t lo = vtr(vimg + vbase0 + xo + 4096u * kk), hh = vtr(vimg + vbase1 + xo + 4096u * kk);
                    const bf16x8 vf = (bf16x8){lo[0], lo[1], lo[2], lo[3], hh[0], hh[1], hh[2], hh[3]};
                    st.o[dt] = MFMA32(vf, pf[kk], st.o[dt]);
                }
            }
        }
        if (more) BA_WRITE(((step + 1) & 1) * 65536 + 32768);
        __syncthreads();
    }
#undef BA_LOAD
#undef BA_WRITE
    LAS float* part = (LAS float*)(F.lds + RING_OFF);
    if (sub != 0) { LAS float* p = part + ((g * 3 + sub - 1) * 66) * 64 + lane; p[0] = st.m; p[64] = st.l;
#pragma unroll
        for (int dt = 0; dt < 4; ++dt)
#pragma unroll
            for (int i = 0; i < 16; ++i) p[(2 + dt * 16 + i) * 64] = st.o[dt][i]; }
    __syncthreads();
    if (sub == 0) {
#pragma unroll 1
        for (int k = 0; k < 3; ++k) { const LAS float* p = part + ((g * 3 + k) * 66) * 64 + lane;
            const float mi = p[0], li = p[64], mnew = fmaxf(st.m, mi), muse = (mnew == -INFINITY) ? 0.f : mnew, a0 = ex2(st.m - muse), a1 = ex2(mi - muse);
            st.l = st.l * a0 + li * a1; st.m = mnew;
#pragma unroll
            for (int dt = 0; dt < 4; ++dt)
#pragma unroll
                for (int i = 0; i < 16; ++i) st.o[dt][i] = st.o[dt][i] * a0 + p[(2 + dt * 16 + i) * 64] * a1; }
        const float ltot = st.l + __shfl_xor(st.l, 32);
        attn_store<128>(st, 1.f / ltot, F.PROJ + row * LDP + C_GATE + 1024 + hd * 128, F.Y + row * DM + 1024 + hd * 128, hi);
    }
    __syncthreads();
}

DI unsigned swz64(unsigned row) { const unsigned y = (row >> 1) & 7u; return y ^ ((y & 1u) << 2); }
DI unsigned off_c(unsigned row, unsigned ch) { return 128u * row + 16u * (ch ^ swz64(row)); }
DI void aattn_item(Frame& F, const int b, const int c, const int grp) {
    int tid = F.tid; asm volatile("" : "+v"(tid));
    const int lane = tid & 63, q = lane & 31, hi = lane >> 5, a = grp * 8 + F.wave;
    const float sink2 = F.sinks[a] * LOG2E, c1 = 0.125f * LOG2E;
    const int smin = c >= 2 ? 0 : (2 - c) * 2;
    LAS unsigned char* const kimg = F.lds + RING_OFF; LAS unsigned char* const vimg = kimg + 24576;
#pragma unroll
    for (int i = 0; i < 3; ++i) { const int n = tid + 512 * i, r = n >> 3, ch = n & 7; const long kpos = (long)(c - 2) * 64 + r;
        if (kpos >= 0) { const bf16* src = F.PROJ + ((size_t)b * SEQ + kpos) * LDP + C_AK + grp * 64 + 8 * ch;
            const v4u kv = *(const GAS v4u*)src, vv = *(const GAS v4u*)(src + (C_AV - C_AK));
            *(LAS v4u*)(kimg + off_c((unsigned)r, (unsigned)ch)) = kv; *(LAS v4u*)(vimg + off_c((unsigned)r, (unsigned)ch)) = vv; } }
    __syncthreads();
    const unsigned qq = (unsigned)((lane & 15) >> 2), p4 = (unsigned)(lane & 3), blk = (unsigned)((lane >> 4) & 1);
#pragma unroll 1
    for (int g = 0; g < 2; ++g) {
        const int qin = c * 64 + g * 32 + q; const size_t row = (size_t)b * SEQ + qin;
        bf16x8 qf[4];
#pragma unroll
        for (int ks = 0; ks < 4; ++ks) qf[ks] = *(const GAS bf16x8*)(F.PROJ + row * LDP + C_AQ + a * 64 + 16 * ks + 8 * hi);
        ASt<64> st; ast_init(st);
        const float* btab = F.BIASA + ((size_t)(a * 64 + g * 32 + q)) * 192 + 4 * hi;
#pragma unroll 1
        for (int s = smin; s < 6; ++s) {
            const unsigned rk = (unsigned)(32 * s + q);
            f32x16 x;
#pragma unroll
            for (int i = 0; i < 16; ++i) x[i] = 0.f;
#pragma unroll
            for (int ks = 0; ks < 4; ++ks) { const bf16x8 kf = *(const LAS bf16x8*)(kimg + off_c(rk, (unsigned)(2 * ks + hi))); x = MFMA32(kf, qf[ks], x); }
#pragma unroll
            for (int g4 = 0; g4 < 4; ++g4) { const f32x4 bv = *(const GAS f32x4*)(btab + 32 * s + 8 * g4);
#pragma unroll
                for (int j = 0; j < 4; ++j) x[4 * g4 + j] = fmaf(x[4 * g4 + j], c1, bv[j]); }
            bf16x8 pf[2];
            softmax_upd<64>(st, x, pf[0], pf[1]);
#pragma unroll
            for (int kk = 0; kk < 2; ++kk)
#pragma unroll
                for (int dt = 0; dt < 2; ++dt) {
                    const unsigned r0 = (unsigned)(32 * s + 16 * kk + 4 * hi) + qq, chv = (unsigned)(4 * dt) + 2u * blk + (p4 >> 1);
                    const v4i16_t lo = vtr(vimg + off_c(r0, chv) + 8u * (p4 & 1u)), hh = vtr(vimg + off_c(r0 + 8u, chv) + 8u * (p4 & 1u));
                    const bf16x8 vf = (bf16x8){lo[0], lo[1], lo[2], lo[3], hh[0], hh[1], hh[2], hh[3]};
                    st.o[dt] = MFMA32(vf, pf[kk], st.o[dt]);
                }
        }
        const float mf = fmaxf(st.m, sink2), a0 = ex2(st.m - mf);
        const float ltot = (st.l + __shfl_xor(st.l, 32)) * a0 + ex2(sink2 - mf);
        attn_store<64>(st, a0 / ltot, F.PROJ + row * LDP + C_GATE + a * 64, F.Y + row * DM + a * 64, hi);
    }
    __syncthreads();
}
DI void cattn_item(Frame& F, const int b, const int hd, const int qblk) {
    int tid = F.tid; asm volatile("" : "+v"(tid));
    const int lane = tid & 63, q = lane & 31, hi = lane >> 5;
    const float c1 = 0.08838834764831845f * LOG2E;
    LAS unsigned char* const kimg = F.lds + RING_OFF; LAS unsigned char* const vimg = kimg + 65536;
#pragma unroll 2
    for (int i = 0; i < 8; ++i) { const int n = tid + 512 * i, r = n >> 4, ch = n & 15;
        const bf16* src = F.MKV + ((size_t)(b * NMEM + r)) * 1024 + hd * 128 + 8 * ch;
        const v4u kv = *(const GAS v4u*)src, vv = *(const GAS v4u*)(src + 512);
        *(LAS v4u*)(kimg + off_b((unsigned)r, (unsigned)ch)) = kv; *(LAS v4u*)(vimg + off_b((unsigned)r, (unsigned)ch)) = vv; }
    const size_t row = (size_t)b * SEQ + qblk * 256 + F.wave * 32 + q;
    bf16x8 qf[8];
#pragma unroll
    for (int ks = 0; ks < 8; ++ks) qf[ks] = *(const GAS bf16x8*)(F.PROJ + row * LDP + C_CQ + hd * 128 + 16 * ks + 8 * hi);
    ASt<128> st; ast_init(st);
    __syncthreads();
    const unsigned qq = (unsigned)((lane & 15) >> 2), p4 = (unsigned)(lane & 3), blk = (unsigned)((lane >> 4) & 1);
#pragma unroll 1
    for (int s = 0; s < 8; ++s) {
        const unsigned rk = (unsigned)(32 * s + q);
        f32x16 x;
#pragma unroll
        for (int i = 0; i < 16; ++i) x[i] = 0.f;
#pragma unroll
        for (int ks = 0; ks < 8; ++ks) { const bf16x8 kf = *(const LAS bf16x8*)(kimg + off_b(rk, (unsigned)(2 * ks + hi))); x = MFMA32(kf, qf[ks], x); }
#pragma unroll
        for (int i = 0; i < 16; ++i) x[i] *= c1;
        bf16x8 pf[2];
        softmax_upd<128>(st, x, pf[0], pf[1]);
#pragma unroll
        for (int kk = 0; kk < 2; ++kk)
#pragma unroll
            for (int dt = 0; dt < 4; ++dt) {
                const unsigned r0 = (unsigned)(32 * s + 16 * kk + 4 * hi) + qq, chv = (unsigned)(4 * dt) + 2u * blk + (p4 >> 1);
                const v4i16_t lo = vtr(vimg + off_b(r0, chv) + 8u * (p4 & 1u)), hh = vtr(vimg + off_b(r0 + 8u, chv) + 8u * (p4 & 1u));
                const bf16x8 vf = (bf16x8){lo[0], lo[1], lo[2], lo[3], hh[0], hh[1], hh[2], hh[3]};
                st.o[dt] = MFMA32(vf, pf[kk], st.o[dt]);
            }
    }
    const float ltot = st.l + __shfl_xor(st.l, 32);
    attn_store<128>(st, 1.f / ltot, F.PROJ + row * LDP + C_GATE + 1536 + hd * 128, F.Y + row * DM + 1536 + hd * 128, hi);
    __syncthreads();
}

DI f32x16 idx_tile(const bf16x8 (&kf)[4], const bf16x8 (&qf)[4][4], const float (&w)[4]) {
    f32x16 isc;
#pragma unroll
    for (int h4 = 0; h4 < 4; ++h4) {
        f32x16 s;
#pragma unroll
        for (int i = 0; i < 16; ++i) s[i] = 0.f;
#pragma unroll
        for (int ks = 0; ks < 4; ++ks) s = MFMA32(kf[ks], qf[h4][ks], s);
#pragma unroll
        for (int i = 0; i < 16; ++i) { const int vi = __float_as_int(s[i]); const float v = __int_as_float(vi > 0 ? vi : 0);     isc[i] = (h4 == 0) ? v * w[0] : __builtin_fmaf(v, w[h4], isc[i]); }
    }
#pragma unroll
    for (int i = 0; i < 16; ++i) isc[i] += 0.f;
    return isc;
}
DI void idx_load(bf16x8 (&kf)[4], const bf16* ikrow) {
#pragma unroll
    for (int ks = 0; ks < 4; ++ks) kf[ks] = *(const GAS bf16x8*)(ikrow + 16 * ks);
}
DI unsigned sortable(float v) { const unsigned u = __float_as_uint(v); return u ^ ((unsigned)((int)u >> 31) | 0x80000000u); }
DI unsigned long long comp_key(float v, int key) { return ((unsigned long long)sortable(v) << 16) | (unsigned long long)(0xFFFFu - (unsigned)key); }
template <int NS> DI void sel_resolve(const LAS unsigned* lq, LAS unsigned* mq, const unsigned n, const unsigned need, const int lane) {
    unsigned e[NS];
#pragma unroll
    for (int j = 0; j < NS; ++j) e[j] = ((unsigned)(lane + 64 * j) < n) ? lq[lane + 64 * j] : 0u;
    unsigned thr = 0u;
#pragma unroll 1
    for (int bit = 31; bit >= 0; --bit) {
        const unsigned cand = thr | (1u << bit); unsigned cntge = 0u;
#pragma unroll
        for (int j = 0; j < NS; ++j) cntge += (unsigned)__popcll(__ballot(e[j] >= cand));
        if (cntge >= need) thr = cand;
    }
#pragma unroll
    for (int j = 0; j < NS; ++j) if ((unsigned)(lane + 64 * j) < n && e[j] >= thr) { const unsigned idx = 4095u - (e[j] & 0xFFFu);
        __hip_atomic_fetch_or(mq + (idx >> 5), 1u << (idx & 31u), __ATOMIC_RELAXED, __HIP_MEMORY_SCOPE_WORKGROUP); }
}
DI bool hist_scan(const LAS unsigned* hist, const int qi, const unsigned r, const int lane, int& bin, unsigned& run, unsigned& cnt) {
    const int b0 = 255 - 4 * lane;
    const unsigned c0 = hist[(b0) * 32 + qi], c1 = hist[(b0 - 1) * 32 + qi], c2 = hist[(b0 - 2) * 32 + qi], c3 = hist[(b0 - 3) * 32 + qi];
    const unsigned sum = c0 + c1 + c2 + c3; unsigned incl = sum;
#pragma unroll
    for (int o = 1; o < 64; o <<= 1) { const unsigned t = __shfl_up(incl, o); if (lane >= o) incl += t; }
    const unsigned ex = incl - sum;
    run = ex; cnt = c0; int d = 0;
    if (run + c0 < r) { run += c0; d = 1; cnt = c1; if (run + c1 < r) { run += c1; d = 2; cnt = c2; if (run + c2 < r) { run += c2; d = 3; cnt = c3; } } }
    bin = b0 - d;
    return ex < r && r <= incl;
}
constexpr int SEL_CAP = 512, SEL_E0 = 920;
DI int sel_bin(const unsigned u) {
    const unsigned a = u & 0x7FFFFFFFu;
    int m1 = (int)(a >> 20) - (SEL_E0 - 2); m1 = m1 < 1 ? 1 : (m1 > 127 ? 127 : m1);
    const int sg = (int)u >> 31;
    const int bb = ((m1 ^ sg) - sg) + 128;
    return a == 0u ? 128 : bb;
}
DI bool sel_bin_exact(const int bin) { return (bin >= 2 && bin <= 126) || bin == 128 || (bin >= 130 && bin <= 254); }
DI unsigned sel_bin_lo(const int bin) {
    if (bin == 128) return 0x80000000u;
    if (bin >= 130) return (unsigned)(0x800 + (bin - 128) + SEL_E0 - 2) << 20;
    return (unsigned)(0x7FF - ((128 - bin) + SEL_E0 - 2)) << 20;
}
DI unsigned sel_bin_hi(const int bin) { return bin == 128 ? 0x80000001u : sel_bin_lo(bin) + (1u << 20); }
constexpr int ST_PLO = 0, ST_PHI = 32, ST_R = 64, ST_DONE = 96, ST_TLO0 = 128, ST_TLO1 = 160, ST_THI0 = 192, ST_THI1 = 224, ST_NEED = 256, ST_CNT = 288;
#ifdef PROBE_SEL
#define SEL_T(k) do { const unsigned long long t_ = __builtin_amdgcn_s_memrealtime(); if ((k) == PROBE_SEL) F.pacc += t_ - tsec; tsec = t_; } while (0)
#else
#define SEL_T(k) do {} while (0)
#endif
DI void sel_item(Frame& F, const int b, const int c, const int g) {
#ifdef PROBE_SEL
    unsigned long long tsec = __builtin_amdgcn_s_memrealtime();
#endif
    int tid = F.tid; asm volatile("" : "+v"(tid));
    const int lane = tid & 63, q = lane & 31, hi = lane >> 5, wave = F.wave;
    const int t0 = c * 64 + g * 32, nsub = 2 * (c + 1);
    const size_t row0 = (size_t)b * SEQ + t0, row = row0 + q;
    if (c <= 3) {
        unsigned* mrow = F.MASK + row * 128;
        for (int s = wave; s < nsub; s += NWAVES) if (hi == 0) mrow[s] = 0xFFFFFFFFu;
        return;
    }
    bf16x8 qf[4][4];
#pragma unroll
    for (int h4 = 0; h4 < 4; ++h4)
#pragma unroll
        for (int ks = 0; ks < 4; ++ks) qf[h4][ks] = *(const GAS bf16x8*)(F.PROJ + row * LDP + C_IQ + h4 * 64 + 16 * ks + 8 * hi);
    float w[4];
    { const u32x2 wv = *(const GAS u32x2*)(F.PROJ + row * LDP + C_IW);
      w[0] = bf2f(wv.x & 0xffffu) * 0.0625f; w[1] = bf2f(wv.x >> 16) * 0.0625f; w[2] = bf2f(wv.y & 0xffffu) * 0.0625f; w[3] = bf2f(wv.y >> 16) * 0.0625f; }
    const bf16* ikbase = F.IK + ((size_t)b * SEQ + q) * 64 + 8 * hi;
    LAS unsigned* hist = (LAS unsigned*)(F.lds + RING_OFF);
    LAS unsigned* list = (LAS unsigned*)(F.lds + RING_OFF);
    LAS unsigned* mimg = (LAS unsigned*)(F.lds + RING_OFF + 65536);
    volatile LAS unsigned* stt = (volatile LAS unsigned*)(F.lds + RING_OFF + 81920);
    bf16x8 kf[4];
    for (int i = tid; i < 256 * 32; i += NWAVES * 64) hist[i] = 0u;
    __syncthreads();
    if (wave < nsub) idx_load(kf, ikbase + (size_t)(32 * wave) * 64);
#pragma unroll 1
    for (int s = wave; s < nsub; s += NWAVES) {
        const f32x16 isc = idx_tile(kf, qf, w);
        if (s + NWAVES < nsub) idx_load(kf, ikbase + (size_t)(32 * (s + NWAVES)) * 64);
#pragma unroll
        for (int i = 0; i < 16; ++i) __hip_atomic_fetch_add(hist + sel_bin(__float_as_uint(isc[i])) * 32 + q, 1u, __ATOMIC_RELAXED, __HIP_MEMORY_SCOPE_WORKGROUP);
    }
    __syncthreads();
#pragma unroll 1
    for (int qq = 0; qq < 4; ++qq) {
        const int qi = wave * 4 + qq; int bin; unsigned run, cnt;
        if (hist_scan(hist, qi, 256u, lane, bin, run, cnt)) {
            const unsigned rnew = 256u - run;
            const bool fast = sel_bin_exact(bin) && cnt <= (unsigned)SEL_CAP;
            const unsigned long long tl = (unsigned long long)sel_bin_lo(bin) << 16, th = (cnt == rnew) ? tl : (unsigned long long)sel_bin_hi(bin) << 16;
            stt[ST_PLO + qi] = 0u; stt[ST_PHI + qi] = 0u; stt[ST_R + qi] = 256u; stt[ST_DONE + qi] = fast ? 1u : 0u;
            stt[ST_TLO0 + qi] = (unsigned)tl; stt[ST_TLO1 + qi] = (unsigned)(tl >> 32); stt[ST_THI0 + qi] = (unsigned)th; stt[ST_THI1 + qi] = (unsigned)(th >> 32);
            stt[ST_NEED + qi] = (fast && cnt != rnew) ? rnew : 0u; stt[ST_CNT + qi] = 0u;
        }
    }
    __syncthreads();
    SEL_T(0);
    if (!__all(stt[ST_DONE + q] != 0u)) {
#pragma unroll 1
        for (int pass = 0; pass < 6; ++pass) {
            const int sh = 40 - 8 * pass;
            for (int i = tid; i < 256 * 32; i += NWAVES * 64) hist[i] = 0u;
            __syncthreads();
            const unsigned long long prefix = ((unsigned long long)stt[ST_PHI + q] << 32) | stt[ST_PLO + q];
            const bool active = stt[ST_DONE + q] == 0u;
#pragma unroll 1
            for (int s = wave; s < nsub; s += NWAVES) {
                idx_load(kf, ikbase + (size_t)(32 * s) * 64);
                const f32x16 isc = idx_tile(kf, qf, w);
#pragma unroll
                for (int i = 0; i < 16; ++i) {
                    const unsigned long long ck = comp_key(isc[i], 32 * s + crow(i, hi));
                    if (active && ((ck >> (sh + 8)) == prefix)) __hip_atomic_fetch_add(hist + ((unsigned)(ck >> sh) & 255u) * 32 + q, 1u, __ATOMIC_RELAXED, __HIP_MEMORY_SCOPE_WORKGROUP);
                }
            }
            __syncthreads();
#pragma unroll 1
            for (int qq = 0; qq < 4; ++qq) {
                const int qi = wave * 4 + qq;
                if (stt[ST_DONE + qi] != 0u) continue;
                int bin; unsigned run, cnt;
                if (hist_scan(hist, qi, stt[ST_R + qi], lane, bin, run, cnt)) {
                    const unsigned rnew = stt[ST_R + qi] - run;
                    const unsigned long long pref = ((((unsigned long long)stt[ST_PHI + qi] << 32) | stt[ST_PLO + qi]) << 8) | (unsigned long long)bin;
                    stt[ST_PLO + qi] = (unsigned)pref; stt[ST_PHI + qi] = (unsigned)(pref >> 32); stt[ST_R + qi] = rnew;
                    if (cnt == rnew) { const unsigned long long thr = pref << sh; stt[ST_DONE + qi] = 1u;
                        stt[ST_TLO0 + qi] = (unsigned)thr; stt[ST_TLO1 + qi] = (unsigned)(thr >> 32); stt[ST_THI0 + qi] = (unsigned)thr; stt[ST_THI1 + qi] = (unsigned)(thr >> 32); }
                }
            }
            __syncthreads();
            if (__all(stt[ST_DONE + q] != 0u)) break;
        }
    }
    SEL_T(1);
    const unsigned long long tlo = ((unsigned long long)stt[ST_TLO1 + q] << 32) | stt[ST_TLO0 + q], thi = ((unsigned long long)stt[ST_THI1 + q] << 32) | stt[ST_THI0 + q];
    const unsigned klo = (unsigned)(tlo >> 16);
    const bool tie = (thi & 0xFFFFull) != 0ull;
    const unsigned cA = tie ? (unsigned)(thi >> 16) : (unsigned)(thi >> 16) - 1u; const int cB = tie ? (int)(thi & 0xFFFFull) : 0x20000;
    const unsigned cL = (tlo != thi) ? klo : 0xFFFFFFFFu;
    if (wave < nsub) idx_load(kf, ikbase + (size_t)(32 * wave) * 64);
#pragma unroll 1
    for (int s = wave; s < nsub; s += NWAVES) {
        const f32x16 isc = idx_tile(kf, qf, w);
        if (s + NWAVES < nsub) idx_load(kf, ikbase + (size_t)(32 * (s + NWAVES)) * 64);
        unsigned mb = 0u;
        const int invs = 0xFFFF - 32 * s - 4 * hi, dB = invs - cB;
#pragma unroll
        for (int i = 0; i < 16; ++i) {
            const unsigned key = sortable(isc[i]);
            const bool def = key > cA || (key == cA && dB >= (i & 3) + 8 * (i >> 2));
            mb |= def ? (1u << crow(i, hi)) : 0u;
            if (!def && key >= cL) { const unsigned pos = __hip_atomic_fetch_add((LAS unsigned*)(stt + ST_CNT + q), 1u, __ATOMIC_RELAXED, __HIP_MEMORY_SCOPE_WORKGROUP);
                if (pos < (unsigned)SEL_CAP) list[q * SEL_CAP + pos] = ((key - klo) << 12) | (unsigned)((invs - ((i & 3) + 8 * (i >> 2))) & 0xFFF); }
        }
        mb |= (unsigned)__shfl_xor((int)mb, 32);
        if (hi == 0) mimg[q * 128 + s] = mb;
    }
    __syncthreads();
    SEL_T(2);
#pragma unroll 1
    for (int qq = 0; qq < 4; ++qq) {
        const int qi = wave * 4 + qq; const unsigned need = stt[ST_NEED + qi];
        if (need == 0u) continue;
        const unsigned n = stt[ST_CNT + qi];
        const int nslot = (int)((n + 63u) >> 6);
        const LAS unsigned* lq = list + qi * SEL_CAP;
        if (nslot <= 1) sel_resolve<1>(lq, mimg + qi * 128, n, need, lane);
        else if (nslot <= 2) sel_resolve<2>(lq, mimg + qi * 128, n, need, lane);
        else if (nslot <= 4) sel_resolve<4>(lq, mimg + qi * 128, n, need, lane);
        else sel_resolve<8>(lq, mimg + qi * 128, n, need, lane);
    }
    __syncthreads();
    SEL_T(3);
    { const int qr = tid >> 4; unsigned* mrow = F.MASK + (row0 + qr) * 128;
      for (int s = tid & 15; s < nsub; s += 16) mrow[s] = mimg[qr * 128 + s]; }
    __syncthreads();
}

struct ProjOrder {
    pg8::StaticOrder so;
    __device__ void init(int G, int c) { so.init(MTOK, LDP, G, c); }
    __device__ bool next(int i, pg8::Unit& u) const {
        long L = (long)i * so.G + so.c;
        if (L < so.nwg) return so.next(i, u);
        L -= so.nwg; if (L >= 8) return false;
        u.pm = 32 + (int)(L >> 2); u.pn = 23 + (int)(L & 3); return true;
    }
    __device__ __forceinline__ void a_ready(const pg8::Unit&) const {}
    __device__ __forceinline__ void done(const pg8::Unit&) const {}
};

struct Args { const float* in[10]; float* out; unsigned char* ws; int ph_lo, ph_hi, li, pad; };
__global__ void __launch_bounds__(NWAVES * 64, 2) hyb_fwd(Args args) {
    extern __shared__ __attribute__((aligned(16))) unsigned char lds[];
    Frame F;
    F.lds = (LAS unsigned char*)lds;
    F.MISC = (volatile LAS unsigned*)(F.lds + MISC_OFF);
    F.pacc = 0; F.tid = threadIdx.x; F.lane = F.tid & 63; F.wave = __builtin_amdgcn_readfirstlane(F.tid >> 6);
    F.G = gridDim.x; { const int bx = blockIdx.x; F.vcu = (F.G % 8 == 0) ? (bx % 8) * (F.G / 8) + bx / 8 : bx; }
    unsigned char* ws = args.ws;
    F.ctl = (gu32*)(ws + WS_CTL);
    F.x = args.in[0]; F.mem = args.in[1]; F.g_norm = args.in[2]; F.w_in = args.in[3]; F.sinks = args.in[4]; F.rel_bias = args.in[5];
    F.g_mem = args.in[6]; F.w_mem_kv = args.in[7]; F.w_out = args.in[8]; F.g_final = args.in[9]; F.out = args.out;
    F.WinT = (bf16*)(ws + WS_WINT); F.WmemT = (bf16*)(ws + WS_WMEMT); F.WoutT = (bf16*)(ws + WS_WOUTT); F.XN = (bf16*)(ws + WS_XN); F.MEMN = (bf16*)(ws + WS_MEMN);
    F.PROJ = (bf16*)(ws + WS_PROJ); F.MKV = (bf16*)(ws + WS_MKV); F.IK = (bf16*)(ws + WS_IK);
    F.Y = (bf16*)(ws + WS_Y); F.MASK = (unsigned*)(ws + WS_MASK); F.BIASA = (float*)(ws + WS_BIASA); F.BIASB = (float*)(ws + WS_BIASB); F.SSQ = (float*)(ws + WS_SSQ);
    for (int u = F.tid; u < (LDS_BYTES - LDSCTL_OFF) / 4; u += NWAVES * 64) ((LAS unsigned*)(F.lds + LDSCTL_OFF))[u] = 0u;
    __syncthreads();
    XcdBarrier bar; bar.bar = (unsigned*)(F.ctl + CW_BAR); bar.x = 0; bar.st = nullptr;
    if (N_LAUNCHES == 1) bar = xcd_barrier_post((unsigned*)(F.ctl + CW_BAR), F.MISC + 8);
#define GRID_BAR() do { if (N_LAUNCHES == 1) xcd_barrier(bar); } while (0)
    const int lo = args.ph_lo, hi = args.ph_hi;
#define IN(k) (lo <= (k) && (k) < hi)
#define BOTH(k) (IN(k) && IN((k) + 1))
#ifdef PROBE_ITEM
    unsigned long long pr_acc = 0;
#endif
#ifdef PROBE_PHASE
    unsigned long long pr_a = 0, pr_b = 0;
#define PH_BEGIN(k) do { if ((k) == PROBE_PHASE) pr_a = __builtin_amdgcn_s_memrealtime(); } while (0)
#define PH_END(k) do { if ((k) == PROBE_PHASE) pr_b = __builtin_amdgcn_s_memrealtime(); } while (0)
#else
#define PH_BEGIN(k) do {} while (0)
#define PH_END(k) do {} while (0)
#endif

    if (IN(0)) { PH_BEGIN(0); p0_prologue(F); if (BOTH(0)) GRID_BAR(); PH_END(0); }

    if (IN(1)) {
        PH_BEGIN(1);
        pg8::Gemm g{F.XN, F.WinT, MTOK + MMEM, LDP + 1024, DM}; ProjOrder S; S.init(F.G, (int)blockIdx.x);
        pg8::EpiProj E{F.PROJ, F.MKV, F.IK};
        pg8::gemm_phase<pg8::EpiProj, ProjOrder, true, true>(F.lds + RING_OFF, g, S, E);
        if (BOTH(1)) GRID_BAR();
        PH_END(1);
    }

    if (IN(2)) {
        PH_BEGIN(2);
        for (;;) {
            if (F.tid == 0) F.MISC[0] = __hip_atomic_fetch_add(F.ctl + CW_Q, 1u, RLX_AGENT);
            __syncthreads();
            const int it = (int)F.MISC[0];
            __syncthreads();
            if (it >= 640) break;
#ifdef PROBE_ITEM
            const unsigned long long pi0 = __builtin_amdgcn_s_memrealtime();
#endif
            if (it < 256) sel_item(F, (it >> 1) & 1, 63 - (it >> 2), it & 1);
            else if (it < 512) { const int j = it - 256; aattn_item(F, j >> 7, (j >> 1) & 63, j & 1); }
            else { const int j = it - 512; cattn_item(F, j >> 6, (j >> 4) & 3, j & 15); }
#ifdef PROBE_ITEM
            if ((it < 256 ? 0 : (it < 512 ? 1 : 2)) == PROBE_ITEM) pr_acc += __builtin_amdgcn_s_memrealtime() - pi0;
#endif
        }
        if (BOTH(2)) GRID_BAR();
        PH_END(2);
    }

    if (IN(3)) {
        PH_BEGIN(3);
        for (int k = F.vcu; k < 256; k += F.G) { const int hd = (k >> 5) & 3, b = k >> 7, cp = k & 31;     battn_chunk(F, b, 63 - cp, hd); battn_chunk(F, b, cp, hd); }
        if (BOTH(3)) GRID_BAR();
        PH_END(3);
    }

    if (IN(4)) {
        PH_BEGIN(4);
        pg8::Gemm g{F.Y, F.WoutT, MTOK, DM, DM}; pg8::StaticOrder S; S.init(MTOK, DM, F.G, (int)blockIdx.x);
        pg8::EpiOut E{F.x, F.out, F.SSQ};
        pg8::gemm_phase<pg8::EpiOut, pg8::StaticOrder, true, true>(F.lds + RING_OFF, g, S, E);
        if (BOTH(4)) GRID_BAR();
        PH_END(4);
    }

    if (IN(5)) {
        PH_BEGIN(5);
        const int gw = F.vcu * NWAVES + F.wave, NGW = F.G * NWAVES;
        for (int m = gw; m < MTOK; m += NGW) {
            const float part = (F.lane < 32) ? F.SSQ[(size_t)m * 32 + F.lane] : 0.f;
            const float rstd = 1.f / sqrtf(wave_sum(part) * (1.f / DM) + EPS);
            GAS f32x4* o = (GAS f32x4*)(F.out + (size_t)m * DM) + F.lane; const GAS f32x4* gr = (const GAS f32x4*)F.g_final + F.lane;
#pragma unroll
            for (int j = 0; j < 8; ++j) { const f32x4 hv = o[64 * j], gv = gr[64 * j]; o[64 * j] = hv * rstd * gv; }
        }
    }
#ifdef PROBE_SEL
    { const unsigned long long t0 = __builtin_amdgcn_s_memrealtime(); while (__builtin_amdgcn_s_memrealtime() - t0 < F.pacc) __builtin_amdgcn_s_sleep(4); }
#endif
#ifdef PROBE_ITEM
    { const unsigned long long t0 = __builtin_amdgcn_s_memrealtime(); while (__builtin_amdgcn_s_memrealtime() - t0 < pr_acc) __builtin_amdgcn_s_sleep(4); }
#endif
#ifdef PROBE_PHASE
    if (PROBE_PHASE == 5) pr_b = __builtin_amdgcn_s_memrealtime();
    { const unsigned long long t0 = __builtin_amdgcn_s_memrealtime(), dt = pr_b - pr_a; while (__builtin_amdgcn_s_memrealtime() - t0 < dt) __builtin_amdgcn_s_sleep(4); }
#endif
#undef IN
#undef BOTH
#undef GRID_BAR
}

extern "C" void kernel_launch(void* const* d_in, const int* in_sizes, int n_in, void* d_out, int out_size, void* d_ws, size_t ws_size, hipStream_t stream) {
    static int grid = 0;
    if (grid == 0) {
        if (n_in != 10 || in_sizes[0] != MTOK * DM || out_size != MTOK * DM || ws_size < WS_END) { fprintf(stderr, "kernel_launch: unexpected shapes (n_in %d, in0 %d, out %d, ws %zu); nothing launched\n", n_in, n_in > 0 ? in_sizes[0] : -1, out_size, ws_size); grid = -1; return; }
        int dev = 0, cus = 0, per_cu = 0;
        if (hipGetDevice(&dev) != hipSuccess || hipDeviceGetAttribute(&cus, hipDeviceAttributeMultiprocessorCount, dev) != hipSuccess) { fprintf(stderr, "kernel_launch: device query failed\n"); grid = -1; return; }
        if (hipFuncSetAttribute((const void*)hyb_fwd, hipFuncAttributeMaxDynamicSharedMemorySize, LDS_BYTES) != hipSuccess) { fprintf(stderr, "kernel_launch: hipFuncSetAttribute failed\n"); grid = -1; return; }
        if (hipOccupancyMaxActiveBlocksPerMultiprocessor(&per_cu, (const void*)hyb_fwd, NWAVES * 64, LDS_BYTES) != hipSuccess || per_cu < 1)
            fprintf(stderr, "kernel_launch: note: occupancy query reports %d workgroups per CU\n", per_cu);
        (void)hipGetLastError();
        grid = cus;
    }
    if (grid < 0) return;
    if (hipMemsetAsync((char*)d_ws + WS_CTL, 0, CTL_ZERO_BYTES, stream) != hipSuccess) { fprintf(stderr, "kernel_launch: hipMemsetAsync failed\n"); return; }
    Args a{};
    for (int i = 0; i < 10; ++i) a.in[i] = (const float*)d_in[i];
    a.out = (float*)d_out; a.ws = (unsigned char*)d_ws;
    for (int li = 0; li < N_LAUNCHES; ++li) {
        a.ph_lo = (N_LAUNCHES == N_PHASES) ? li : 0; a.ph_hi = (N_LAUNCHES == N_PHASES) ? li + 1 : N_PHASES; a.li = li;
        hipLaunchKernelGGL(hyb_fwd, dim3(grid), dim3(NWAVES * 64), LDS_BYTES, stream, a);
        const hipError_t le = hipPeekAtLastError();
        if (le != hipSuccess) { fprintf(stderr, "kernel_launch: launch %d failed: %s\n", li, hipGetErrorName(le)); break; }
    }
}
```
